# Optimizing an MI355X kernel written in HIP

```python
import jax, jax.numpy as jnp
from jax import lax
import numpy as np

D_MODEL = 2048
BATCH = 4
SEQ = 2048
DEPTH = 2
DEC_BATCH = 128
DEC_SEQ = 8
PAST_LEN = 16384
PAGE_SIZE = 128

N_MIXERS = 2
N_RET = (DEPTH + 1) // 2
N_POOL = DEPTH // 2
RET_HEADS = 8
RET_DK = D_MODEL // RET_HEADS
RET_DV = 2 * D_MODEL // RET_HEADS
RET_CHUNK = 128
ROPE_BASE = 10000.0
POOL_WINDOWS = (2, 4, 8, 16)
POOL_GROUPS = len(POOL_WINDOWS)
POOL_GC = D_MODEL // POOL_GROUPS
POOL_HIST = max(POOL_WINDOWS) - 1
D_FF = -(-8 * D_MODEL // 768) * 256
N_ADA = 6
EPS = 1e-6

kernel_name = "retention_pool_hybrid_step"


def rmsnorm(x, g):
    xf = x.astype(jnp.float32)
    xf = xf * lax.rsqrt(jnp.mean(xf * xf, axis=-1, keepdims=True) + EPS)
    return (xf * g.astype(jnp.float32)).astype(x.dtype)


def rope(x, pos):
    half = x.shape[-1] // 2
    inv = 1.0 / (ROPE_BASE ** (jnp.arange(half, dtype=jnp.float32) / half))
    ang = pos[:, None] * inv[None, :]
    cos = jnp.cos(ang)[None, :, None, :]
    sin = jnp.sin(ang)[None, :, None, :]
    xf = x.astype(jnp.float32)
    x1, x2 = xf[..., :half], xf[..., half:]
    return jnp.concatenate([x1 * cos - x2 * sin, x1 * sin + x2 * cos], axis=-1)


def retention_decays(C):
    lg = jnp.log1p(-jnp.exp2(-5.0 - jnp.arange(RET_HEADS, dtype=jnp.float32)))
    idx = jnp.arange(C, dtype=jnp.float32)
    diff = idx[:, None] - idx[None, :]
    causal = diff >= 0
    dmask = jnp.where(causal[None], jnp.exp(jnp.where(causal, diff, 0.0)[None] * lg[:, None, None]), 0.0)
    qdec = jnp.exp((idx + 1.0)[None, :] * lg[:, None])
    kdec = jnp.exp((C - 1.0 - idx)[None, :] * lg[:, None])
    sdec = jnp.exp(C * lg)
    return dmask, qdec, kdec, sdec


def retention(h, pos0, S0, w_in, gn_g, w_out, chunk):
    B, T, _ = h.shape
    proj = h @ w_in
    q, k, v, g = jnp.split(proj, [RET_HEADS * RET_DK, 2 * RET_HEADS * RET_DK,
                                  2 * RET_HEADS * RET_DK + RET_HEADS * RET_DV], axis=-1)
    pos = pos0 + jnp.arange(T, dtype=jnp.float32)
    q = rope(q.reshape(B, T, RET_HEADS, RET_DK), pos)
    k = rope(k.reshape(B, T, RET_HEADS, RET_DK), pos) * (RET_DK ** -0.5)
    v = v.reshape(B, T, RET_HEADS, RET_DV).astype(jnp.float32)
    nC = T // chunk

    def to_chunks(a):
        return a.reshape(B, nC, chunk, RET_HEADS, a.shape[-1]).transpose(1, 0, 3, 2, 4)

    dmask, qdec, kdec, sdec = retention_decays(chunk)

    def step(S, xs):
        qc, kc, vc = xs
        scores = jnp.einsum('bhnd,bhmd->bhnm', qc, kc) * dmask[None]
        o = (jnp.einsum('bhnm,bhme->bhne', scores, vc)
             + jnp.einsum('bhnd,bhde->bhne', qc * qdec[None, :, :, None], S))
        S = sdec[None, :, None, None] * S + jnp.einsum('bhmd,bhme->bhde', kc * kdec[None, :, :, None], vc)
        return S, o

    S, o = lax.scan(step, S0.astype(jnp.float32), (to_chunks(q), to_chunks(k), to_chunks(v)))
    o = o.transpose(1, 0, 3, 2, 4).reshape(B, T, RET_HEADS, RET_DV)
    mu = jnp.mean(o, axis=-1, keepdims=True)
    var = jnp.mean(jnp.square(o - mu), axis=-1, keepdims=True)
    o = ((o - mu) * lax.rsqrt(var + EPS)).reshape(B, T, RET_HEADS * RET_DV) * gn_g.astype(jnp.float32)
    out = (jax.nn.silu(g.astype(jnp.float32)) * o).astype(h.dtype) @ w_out
    return out, S.astype(h.dtype)


def pool_mixer(u, hist, hist_len, w, scale):
    B, T, D = u.shape
    P = hist.shape[1]
    full = jnp.concatenate([hist, u], axis=1).astype(jnp.float32)
    cs = jnp.concatenate([jnp.zeros((B, 1, D), jnp.float32), jnp.cumsum(full, axis=1)], axis=1)
    t = jnp.arange(T)
    means = []
    for gi, win in enumerate(POOL_WINDOWS):
        sl = slice(gi * POOL_GC, (gi + 1) * POOL_GC)
        s = cs[:, P + 1:P + 1 + T, sl] - cs[:, P + 1 - win:P + 1 - win + T, sl]
        cnt = jnp.minimum(win, t + 1 + hist_len).astype(jnp.float32)
        means.append(s / cnt[None, :, None])
    m = jnp.concatenate(means, axis=-1) - full[:, P:]
    m = m.reshape(B, T, POOL_GROUPS, POOL_GC).astype(u.dtype)
    y = jnp.einsum('btgc,gce->btge', m, w).reshape(B, T, D) * scale
    new_hist = full[:, -P:].astype(u.dtype)
    return y, new_hist


def swiglu(h, w_in, w_out):
    gate, up = jnp.split(h @ w_in, 2, axis=-1)
    return (jax.nn.silu(gate) * up) @ w_out


def trunk(x, c, pos0, ret_state, pool_state, pool_hist_len, chunk,
          norm_mix_g, norm_ffn_g, ada_w, ada_b, ret_w_in, ret_gn_g, ret_w_out,
          pool_w, pool_scale, ffn_w_in, ffn_w_out, final_norm_g):
    new_ret, new_pool = [], []
    cs = jax.nn.silu(c)
    for i in range(DEPTH):
        mod = cs @ ada_w[i] + ada_b[i]
        sh1, sc1, g1, sh2, sc2, g2 = jnp.split(mod, N_ADA, axis=-1)
        h = rmsnorm(x, norm_mix_g[i]) * (1.0 + sc1[:, None]) + sh1[:, None]
        j = i // N_MIXERS
        if i % N_MIXERS == 0:
            out, s = retention(h, pos0, ret_state[j], ret_w_in[j], ret_gn_g[j], ret_w_out[j], chunk)
            new_ret.append(s)
        else:
            out, s = pool_mixer(h, pool_state[j], pool_hist_len, pool_w[j], pool_scale[j])
            new_pool.append(s)
        x = x + g1[:, None] * out
        h = rmsnorm(x, norm_ffn_g[i]) * (1.0 + sc2[:, None]) + sh2[:, None]
        x = x + g2[:, None] * swiglu(h, ffn_w_in[i], ffn_w_out[i])
    return rmsnorm(x, final_norm_g), jnp.stack(new_ret), jnp.stack(new_pool)


def setup_inputs(seed: int = 0) -> dict:
    key = jax.random.key(seed)
    ks = jax.random.split(key, 20)
    f32 = jnp.float32
    nrm = lambda k, s, sc: jax.random.normal(k, s, f32) * sc
    HQK = RET_HEADS * RET_DK
    HV = RET_HEADS * RET_DV
    return {
        "x_prompt": nrm(ks[0], (BATCH, SEQ, D_MODEL), 1.0),
        "x_sample": nrm(ks[1], (DEC_BATCH, DEC_SEQ, D_MODEL), 1.0),
        "c_prompt": nrm(ks[2], (BATCH, D_MODEL), 1.0),
        "c_sample": nrm(ks[3], (DEC_BATCH, D_MODEL), 1.0),
        "state_ret": nrm(ks[4], (N_RET, DEC_BATCH, RET_HEADS, RET_DK, RET_DV), 0.1),
        "state_pool": nrm(ks[5], (N_POOL, DEC_BATCH, POOL_HIST, D_MODEL), 1.0),
        "norm_mix_g": 1.0 + nrm(ks[6], (DEPTH, D_MODEL), 0.02),
        "norm_ffn_g": 1.0 + nrm(ks[7], (DEPTH, D_MODEL), 0.02),
        "ada_w": nrm(ks[8], (DEPTH, D_MODEL, N_ADA * D_MODEL), 0.3 * D_MODEL ** -0.5),
        "ada_b": nrm(ks[9], (DEPTH, N_ADA * D_MODEL), 0.02),
        "ret_w_in": nrm(ks[10], (N_RET, D_MODEL, 2 * HQK + 2 * HV), D_MODEL ** -0.5),
        "ret_gn_g": 1.0 + nrm(ks[11], (N_RET, HV), 0.02),
        "ret_w_out": nrm(ks[12], (N_RET, HV, D_MODEL), HV ** -0.5),
        "pool_w": nrm(ks[13], (N_POOL, POOL_GROUPS, POOL_GC, POOL_GC), POOL_GC ** -0.5),
        "pool_scale": 1.0 + nrm(ks[14], (N_POOL, D_MODEL), 0.1),
        "ffn_w_in": nrm(ks[15], (DEPTH, D_MODEL, 2 * D_FF), D_MODEL ** -0.5),
        "ffn_w_out": nrm(ks[16], (DEPTH, D_FF, D_MODEL), D_FF ** -0.5),
        "final_norm_g": 1.0 + nrm(ks[17], (D_MODEL,), 0.02),
    }


def reference(x_prompt, x_sample, c_prompt, c_sample, state_ret, state_pool,
              norm_mix_g, norm_ffn_g, ada_w, ada_b, ret_w_in, ret_gn_g, ret_w_out,
              pool_w, pool_scale, ffn_w_in, ffn_w_out, final_norm_g):
    B, T_p, _ = x_prompt.shape
    T_s = x_sample.shape[1]
    ret0 = jnp.zeros((N_RET, B, RET_HEADS, RET_DK, RET_DV), x_prompt.dtype)
    pool0 = jnp.zeros((N_POOL, B, POOL_HIST, D_MODEL), x_prompt.dtype)
    chunk_p = RET_CHUNK if T_p % RET_CHUNK == 0 else T_p
    y_prompt, state_ret_prompt, state_pool_prompt = trunk(
        x_prompt, c_prompt, 0.0, ret0, pool0, 0, chunk_p,
        norm_mix_g, norm_ffn_g, ada_w, ada_b, ret_w_in, ret_gn_g, ret_w_out,
        pool_w, pool_scale, ffn_w_in, ffn_w_out, final_norm_g)
    y_sample, state_ret_sample, state_pool_sample = trunk(
        x_sample, c_sample, float(PAST_LEN), state_ret, state_pool, min(PAST_LEN, POOL_HIST), T_s,
        norm_mix_g, norm_ffn_g, ada_w, ada_b, ret_w_in, ret_gn_g, ret_w_out,
        pool_w, pool_scale, ffn_w_in, ffn_w_out, final_norm_g)
    return (y_prompt, y_sample, state_ret_prompt, state_pool_prompt, state_ret_sample, state_pool_sample)
```

```cpp
#include <hip/hip_runtime.h>
#include <math.h>
#include <stdio.h>
#include <stdint.h>
namespace mk {
#define LAS __attribute__((address_space(3)))
#define GAS __attribute__((address_space(1)))
typedef unsigned short bf16;
typedef short bf16x8 __attribute__((ext_vector_type(8)));
typedef short s16x4 __attribute__((ext_vector_type(4)));
typedef float f32x4 __attribute__((ext_vector_type(4)));
typedef float f32x2 __attribute__((ext_vector_type(2)));
typedef unsigned u32x4 __attribute__((ext_vector_type(4)));
typedef unsigned u32x2 __attribute__((ext_vector_type(2)));
typedef short v4i16_t __attribute__((ext_vector_type(4)));

constexpr int D = 2048, MP = 8192, MS = 1024, M = 9216, NSEQ = 132, NMOD = 12288, NH = 8, DK = 256, DV = 512, FF = 5632, NPROJ = 12288, HV = 4096;
constexpr int NWAVES = 8, NTHREADS = 512;
constexpr size_t MiB = 1u << 20;
constexpr size_t WS_CTL = 0, CTL_ZERO_BYTES = 1 * MiB;
constexpr size_t WS_ROPE = 1 * MiB;
constexpr size_t WS_MOD = 4 * MiB;
constexpr size_t WS_SILU = 17 * MiB;
constexpr size_t WS_WIN = 18 * MiB;
constexpr size_t WS_WOUT = 66 * MiB;
constexpr size_t WS_WF1 = 82 * MiB;
constexpr size_t WS_WF2 = 170 * MiB;
constexpr size_t WS_WPOOL = 214 * MiB;
constexpr size_t WS_A = 216 * MiB;
constexpr size_t WS_Q = 252 * MiB, WS_K = 288 * MiB;
constexpr size_t WS_V = 324 * MiB, WS_G = 396 * MiB;
constexpr size_t WS_O = 468 * MiB;
constexpr size_t WS_A2 = 540 * MiB;
constexpr size_t WS_X1 = 612 * MiB, WS_X2 = 684 * MiB;
constexpr size_t WS_SLAB = 756 * MiB;
constexpr size_t WS_HID = 252 * MiB;
constexpr size_t WS_END = 820 * MiB;
static_assert(WS_HID + (size_t)M * FF * 2 <= WS_G + (size_t)M * HV * 2, "hid overlay");
constexpr int CW_TMO = 0, CW_BAR = 4096, CW_SILU = 8192, CW_ROWSS = 32768;
#ifndef MK_FP8
#define MK_FP8 1
#endif
constexpr bool FP8 = MK_FP8 != 0;
constexpr int FES = FP8 ? 1 : 2;
constexpr float S_H2 = 16.0f, S_W1 = 512.0f, S_HID = 8.0f, S_W2 = 1024.0f, S_A2 = 8.0f, S_WO = 1024.0f;
#ifndef MK_FP8_WOUT
#define MK_FP8_WOUT 1
#endif
constexpr bool FP8O = FP8 && (MK_FP8_WOUT != 0);
constexpr int OES = FP8O ? 1 : 2;

constexpr int LDS_BYTES = 147456, MISC_OFF = 131072 + 320;

#ifndef MK_EXPERIMENT
#define MK_EXPERIMENT 0
#endif
struct Args { const float* in[18]; float* out; unsigned char* ws; int ph_lo, ph_hi, mode, pad; };

__device__ __forceinline__ unsigned pk2(float lo, float hi) { unsigned r; asm("v_cvt_pk_bf16_f32 %0, %1, %2" : "=v"(r) : "v"(lo), "v"(hi)); return r; }
__device__ __forceinline__ unsigned pk4_fp8(float a, float b, float c, float d) {
    a = __builtin_fminf(__builtin_fmaxf(a, -440.f), 440.f); b = __builtin_fminf(__builtin_fmaxf(b, -440.f), 440.f); c = __builtin_fminf(__builtin_fmaxf(c, -440.f), 440.f); d = __builtin_fminf(__builtin_fmaxf(d, -440.f), 440.f);
    int w = 0; w = __builtin_amdgcn_cvt_pk_fp8_f32(a, b, w, false); w = __builtin_amdgcn_cvt_pk_fp8_f32(c, d, w, true); return (unsigned)w; }
__device__ __forceinline__ f32x4 ld_bf4(const bf16* p) { const u32x2 w = *(const u32x2*)p; return (f32x4){__uint_as_float(w.x << 16), __uint_as_float(w.x & 0xffff0000u), __uint_as_float(w.y << 16), __uint_as_float(w.y & 0xffff0000u)}; }
__device__ __forceinline__ float bf2f(unsigned short b) { return __uint_as_float(((unsigned)b) << 16); }
__device__ __forceinline__ float silu_f(float v) { return v * __builtin_amdgcn_rcpf(1.0f + __builtin_amdgcn_exp2f(-1.44269504089f * v)); }
__device__ __forceinline__ int seq_of(int r) { return r < MP ? (r >> 11) : 4 + ((r - MP) >> 3); }
__device__ __forceinline__ float wave_sum(float v) {
#pragma unroll
    for (int o = 1; o < 64; o <<= 1) v += __shfl_xor(v, o);
    return v;
}
#define LDS_WAIT() asm volatile("s_waitcnt lgkmcnt(0)" ::: "memory")
#define VM_WAIT() asm volatile("s_waitcnt vmcnt(0)" ::: "memory")

#define XB_TMO      128
#define XB_XCNT(j)  (256  + 64 * (j))
#define XB_XSUB(j)  (1280 + 64 * (j))
#define XB_XGEN(j)  (2304 + 64 * (j))
#define XB_TOP      3328
#define XB_TOPGEN   3392
#define XCD_BAR_WORDS 3456
#define XB_SPIN_CAP (1u << 18)
__device__ __forceinline__ unsigned xb_ld(unsigned* p)              { return __hip_atomic_load(p, __ATOMIC_RELAXED, __HIP_MEMORY_SCOPE_AGENT); }
__device__ __forceinline__ unsigned xb_add(unsigned* p, unsigned v) { return __hip_atomic_fetch_add(p, v, __ATOMIC_RELAXED, __HIP_MEMORY_SCOPE_AGENT); }
__device__ __forceinline__ unsigned xb_xcc_id() { return (unsigned)__builtin_amdgcn_s_getreg((3 << 11) | 20) & 0xFu; }
#define XB_SPIN(cond, bar) do { unsigned _sp = 0; while (cond) { __builtin_amdgcn_s_sleep(1); \
    if ((++_sp & 255u) == 0u) { if (xb_ld(&(bar)[XB_TMO])) break; if (_sp > XB_SPIN_CAP) { atomicAdd(&(bar)[XB_TMO], 1u); break; } } } } while (0)
struct XcdBarrier { unsigned* bar; unsigned x; volatile LAS unsigned* st; };
__device__ __forceinline__ XcdBarrier xcd_barrier_post(unsigned* bar, volatile LAS unsigned* st) {
    XcdBarrier b; b.bar = bar; b.x = xb_xcc_id(); b.st = st;
    if (threadIdx.x == 0) (void)xb_add(&bar[XB_XCNT(b.x)], 1u);
    return b;
}
__device__ __forceinline__ void xcd_barrier_complete(unsigned* bar, unsigned x, unsigned& nloc, unsigned& nx) {
    const unsigned G = gridDim.x * gridDim.y * gridDim.z;
    unsigned sum, cnt, mine, sp = 0u;
    for (;;) {
        sum = 0u; cnt = 0u; mine = 0u;
#pragma unroll
        for (unsigned j = 0; j < 16; ++j) { const unsigned c = xb_ld(&bar[XB_XCNT(j)]); sum += c; cnt += (c > 0u) ? 1u : 0u; mine = (j == x) ? c : mine; }
        if (sum == G) break;
        __builtin_amdgcn_s_sleep(1);
        if ((++sp & 255u) == 0u) { if (xb_ld(&bar[XB_TMO])) break; if (sp > XB_SPIN_CAP) { atomicAdd(&bar[XB_TMO], 1u); break; } }
    }
    nloc = mine > 0u ? mine : 1u; nx = cnt > 0u ? cnt : 1u;
}
__device__ __forceinline__ void xcd_barrier(const XcdBarrier& b) {
    asm volatile("s_waitcnt vmcnt(0)" ::: "memory");
    __syncthreads();
    if (threadIdx.x == 0) {
        unsigned* bar = b.bar;
        __builtin_amdgcn_s_waitcnt(0);
        unsigned nloc = b.st[0], nx = b.st[1];
        if (nloc == 0u) { xcd_barrier_complete(bar, b.x, nloc, nx); b.st[0] = nloc; b.st[1] = nx; }
        const unsigned old = xb_add(&bar[XB_XSUB(b.x)], 1u);
        const unsigned gen = old / nloc;
        if (old + 1u == (gen + 1u) * nloc) {
            __builtin_amdgcn_fence(__ATOMIC_RELEASE, "agent");
            asm volatile("s_waitcnt vmcnt(0)" ::: "memory");
            const unsigned og = xb_add(&bar[XB_TOP], 1u);
            const unsigned tg = og / nx;
            if (og + 1u == (tg + 1u) * nx) xb_add(&bar[XB_TOPGEN], 1u);
            else XB_SPIN(xb_ld(&bar[XB_TOPGEN]) == tg, bar);
            __builtin_amdgcn_fence(__ATOMIC_ACQUIRE, "agent");
            xb_add(&bar[XB_XGEN(b.x)], 1u);
            asm volatile("s_waitcnt vmcnt(0)" ::: "memory");
        } else {
            XB_SPIN(xb_ld(&bar[XB_XGEN(b.x)]) == gen, bar);
            __builtin_amdgcn_fence(__ATOMIC_ACQUIRE, "agent");
            asm volatile("s_waitcnt vmcnt(0)" ::: "memory");
        }
    }
    __syncthreads();
}

struct Frame {
    LAS unsigned char* lds;
    int tid, lane, wave, vcu, G, mode;
    const float *x_p, *x_s, *c_p, *c_s, *state_ret, *state_pool, *norm_mix_g, *norm_ffn_g, *ada_w, *ada_b, *ret_w_in, *ret_gn_g, *ret_w_out, *pool_w, *pool_scale, *ffn_w_in, *ffn_w_out, *final_g;
    float *y, *sr_p, *sp_p, *sr_s, *sp_s;
    unsigned char* ws;
};
#define WSP(T, off) ((T*)(F.ws + (off)))

struct TItem { const float* src; unsigned char* dst; int ldw, ldt, fp8; float scale; };
constexpr int TI_WIN = 32 * 384, TI_WOUT = 64 * 64, TI_F1 = 32 * 352, TI_F2 = 88 * 64, TI_POOL = 4 * 8 * 16;
constexpr int TI_TOTAL = TI_WIN + TI_WOUT + 2 * TI_F1 + 2 * TI_F2 + TI_POOL;
static_assert(TI_TOTAL == 50688 && 128 * 128 == TI_WIN + TI_WOUT, "transpose item count");
constexpr int TR_P0_END = TI_WIN + TI_WOUT, TR_P1_END = TR_P0_END + 4096  , TR_P2_END = TR_P0_END + TI_F1, TR_P7_END = TR_P2_END + TI_F2 + TI_POOL + TI_F1;
__device__ __forceinline__ TItem titem_decode(Frame& F, int it) {
    int r = it; TItem t; t.fp8 = 0; t.scale = 1.0f;
    if (r < TI_WIN) { const int kb = r / 384, nb = r % 384; t.ldw = NPROJ; t.ldt = D * 2; t.src = F.ret_w_in + (size_t)(64 * kb) * NPROJ + 32 * nb; t.dst = F.ws + WS_WIN + ((size_t)(32 * nb) * D + 64 * kb) * 2; return t; } r -= TI_WIN;
    if (r < TI_WOUT) { const int kb = r / 64, nb = r % 64; t.fp8 = FP8O; t.scale = FP8O ? S_WO : 1.0f; t.ldw = D; t.ldt = HV * OES; t.src = F.ret_w_out + (size_t)(64 * kb) * D + 32 * nb; t.dst = F.ws + WS_WOUT + ((size_t)(32 * nb) * HV + 64 * kb) * OES; return t; } r -= TI_WOUT;
    int l = 0;
    if (r >= TI_F1 + TI_F2 + TI_POOL) { l = 1; r -= TI_F1 + TI_F2 + TI_POOL; }
    if (r < TI_F1) { const int kb = r / 352, nb = r % 352, n0 = 32 * nb;
        const int j = n0 < FF ? n0 : n0 - FF; const int row = 256 * (j >> 7) + (j & 127) + (n0 < FF ? 0 : 128);
        t.fp8 = FP8; t.scale = FP8 ? S_W1 : 1.0f;
        t.ldw = 2 * FF; t.ldt = D * FES; t.src = F.ffn_w_in + (size_t)l * D * 2 * FF + (size_t)(64 * kb) * (2 * FF) + n0; t.dst = F.ws + WS_WF1 + ((size_t)l * 2 * FF * D + (size_t)row * D + 64 * kb) * FES; return t; } r -= TI_F1;
    if (r < TI_F2) { const int kb = r / 64, nb = r % 64;
        t.fp8 = FP8; t.scale = FP8 ? S_W2 : 1.0f;
        t.ldw = D; t.ldt = FF * FES; t.src = F.ffn_w_out + (size_t)l * FF * D + (size_t)(64 * kb) * D + 32 * nb; t.dst = F.ws + WS_WF2 + ((size_t)l * D * FF + (size_t)(32 * nb) * FF + 64 * kb) * FES; return t; } r -= TI_F2;
    { const int g = r / 128; r -= g * 128; const int kb = r / 16, nb = r % 16;
        t.ldw = 512; t.ldt = 512 * 2; t.src = F.pool_w + (size_t)g * 512 * 512 + (size_t)(64 * kb) * 512 + 32 * nb; t.dst = F.ws + WS_WPOOL + ((size_t)(512 * g + 32 * nb) * 512 + 64 * kb) * 2; return t; }
}
__device__ __forceinline__ void titem_load(const TItem& t, float (&v)[32], int lane) {
    const float* p = t.src + (size_t)(lane >> 5) * t.ldw + (lane & 31);
#pragma unroll
    for (int i = 0; i < 32; ++i) v[i] = p[(size_t)(2 * i) * t.ldw];
}
__device__ __forceinline__ void titem_finish(const TItem& t, const float (&v)[32], LAS float* scr, int lane) {
#pragma unroll
    for (int i = 0; i < 32; ++i) scr[(2 * i + (lane >> 5)) * 33 + (lane & 31)] = v[i];
    LDS_WAIT(); asm volatile("" ::: "memory");
    const int c = lane & 7;
    if (t.fp8) {
#pragma unroll
        for (int j = 0; j < 4; ++j) { const int n = (lane >> 3) + 8 * j; const LAS float* s = scr + (8 * c) * 33 + n; const float sc = t.scale;
            u32x2 o; o.x = pk4_fp8(s[0 * 33] * sc, s[1 * 33] * sc, s[2 * 33] * sc, s[3 * 33] * sc); o.y = pk4_fp8(s[4 * 33] * sc, s[5 * 33] * sc, s[6 * 33] * sc, s[7 * 33] * sc);
            *(GAS u32x2*)(t.dst + (size_t)n * t.ldt + 8 * c) = o; }
    } else {
#pragma unroll
        for (int j = 0; j < 4; ++j) { const int n = (lane >> 3) + 8 * j; const LAS float* s = scr + (8 * c) * 33 + n;
            u32x4 o; o.x = pk2(s[0 * 33], s[1 * 33]); o.y = pk2(s[2 * 33], s[3 * 33]); o.z = pk2(s[4 * 33], s[5 * 33]); o.w = pk2(s[6 * 33], s[7 * 33]);
            *(GAS u32x4*)(t.dst + (size_t)n * t.ldt + 16 * c) = o; }
    }
    LDS_WAIT(); asm volatile("" ::: "memory");
}
__device__ __forceinline__ void transpose_range(Frame& F, int first, int end, int step, LAS float* scr) {
    if (first >= end) return;
    float cur[32], n1[32], n2[32];
    TItem tc = titem_decode(F, first); titem_load(tc, cur, F.lane);
    TItem t1 = titem_decode(F, first + step < end ? first + step : first); titem_load(t1, n1, F.lane);
    for (int it = first; it < end; it += step) {
        const int it2 = it + 2 * step < end ? it + 2 * step : it;
        const TItem t2 = titem_decode(F, it2); titem_load(t2, n2, F.lane);
        titem_finish(tc, cur, scr, F.lane);
        tc = t1; t1 = t2;
#pragma unroll
        for (int i = 0; i < 32; ++i) { cur[i] = n1[i]; n1[i] = n2[i]; }
    }
}
__device__ __forceinline__ void transpose_tail(Frame& F, int first, int end, int rank, int nidle) {
    if (rank < 0) return;
    transpose_range(F, first + rank * NWAVES + F.wave, end, nidle * NWAVES, (LAS float*)(F.lds + F.wave * 16384));
}
__device__ __forceinline__ void ada_item(Frame& F, int item) {
    const int l = item / 192, n0 = F.mode == 3 ? 0 : (item % 192) * 64;
    const float* W = F.ada_w + (size_t)l * D * NMOD;
    const int kq = F.wave & 3, mh = F.wave >> 2, fr = F.lane & 15, fq = F.lane >> 4;
    f32x4 acc[5][4];
#pragma unroll
    for (int a = 0; a < 5; ++a)
#pragma unroll
        for (int b = 0; b < 4; ++b) acc[a][b] = (f32x4){0.f, 0.f, 0.f, 0.f};
    const float* wp = W + (size_t)(512 * kq + 8 * fq) * NMOD + n0 + 4 * fr;
    const bf16* ap[5];
#pragma unroll
    for (int mt = 0; mt < 5; ++mt) { const int s = 16 * (5 * mh + mt) + fr;
        ap[mt] = WSP(bf16, WS_SILU) + (size_t)(s < 144 ? s : 143) * D + 512 * kq + 8 * fq; }
    f32x4 w4[8]; bf16x8 a4[5];
#pragma unroll
    for (int kk = 0; kk < 8; ++kk) w4[kk] = *(const f32x4*)(wp + (size_t)kk * NMOD);
#pragma unroll
    for (int mt = 0; mt < 5; ++mt) a4[mt] = *(const bf16x8*)(ap[mt]);
#pragma unroll 1
    for (int ks = 0; ks < 16; ++ks) {
        const int ksn = ks + 1 < 16 ? ks + 1 : ks;
        f32x4 wn[8]; bf16x8 an[5];
#pragma unroll
        for (int kk = 0; kk < 8; ++kk) wn[kk] = *(const f32x4*)(wp + (size_t)(ksn * 32 + kk) * NMOD);
#pragma unroll
        for (int mt = 0; mt < 5; ++mt) an[mt] = *(const bf16x8*)(ap[mt] + 32 * ksn);
        bf16x8 bfr[4];
#pragma unroll
        for (int i = 0; i < 4; ++i) { u32x4 p; p.x = pk2(w4[0][i], w4[1][i]); p.y = pk2(w4[2][i], w4[3][i]); p.z = pk2(w4[4][i], w4[5][i]); p.w = pk2(w4[6][i], w4[7][i]); bfr[i] = __builtin_bit_cast(bf16x8, p); }
#pragma unroll
        for (int mt = 0; mt < 5; ++mt)
#pragma unroll
            for (int i = 0; i < 4; ++i) acc[mt][i] = __builtin_amdgcn_mfma_f32_16x16x32_bf16(a4[mt], bfr[i], acc[mt][i], 0, 0, 0);
#pragma unroll
        for (int kk = 0; kk < 8; ++kk) w4[kk] = wn[kk];
#pragma unroll
        for (int mt = 0; mt < 5; ++mt) a4[mt] = an[mt];
    }
    LAS float* red = (LAS float*)F.lds;
    if (kq > 0) {
        LAS float* rp = red + (size_t)((mh * 3 + kq - 1) * 80) * 64 + F.lane;
#pragma unroll
        for (int mt = 0; mt < 5; ++mt)
#pragma unroll
            for (int i = 0; i < 4; ++i)
#pragma unroll
                for (int j = 0; j < 4; ++j) rp[((mt * 4 + i) * 4 + j) * 64] = acc[mt][i][j];
    }
    __syncthreads();
    if (kq == 0) {
#pragma unroll 1
        for (int r = 0; r < 3; ++r) { const LAS float* rp = red + (size_t)((mh * 3 + r) * 80) * 64 + F.lane;
#pragma unroll
            for (int mt = 0; mt < 5; ++mt) {
#pragma unroll
                for (int i = 0; i < 4; ++i)
#pragma unroll
                    for (int j = 0; j < 4; ++j) acc[mt][i][j] += rp[((mt * 4 + i) * 4 + j) * 64];
                asm volatile("" ::: "memory"); } }
        const f32x4 b4 = *(const f32x4*)(F.ada_b + (size_t)l * NMOD + n0 + 4 * fr);
        float* mod = WSP(float, WS_MOD) + (size_t)l * NSEQ * NMOD + n0 + 4 * fr;
#pragma unroll
        for (int mt = 0; mt < 5; ++mt)
#pragma unroll
            for (int j = 0; j < 4; ++j) { const int s = 16 * (5 * mh + mt) + 4 * fq + j;
                if (s < NSEQ) *(f32x4*)(mod + (size_t)s * NMOD) = (f32x4){acc[mt][0][j], acc[mt][1][j], acc[mt][2][j], acc[mt][3][j]} + b4; }
    }
    __syncthreads();
}
static __device__ const float ROPE_INV_FREQ[128] = {
    1.0f, 0.930572033f, 0.865964353f, 0.805842221f, 0.749894202f, 0.697830558f, 0.649381638f, 0.604296386f, 0.562341332f, 0.523299158f, 0.486967534f, 0.453158349f, 0.421696514f, 0.392418981f, 0.365174145f, 0.339820832f, 0.316227764f, 0.294272721f, 0.273841977f, 0.254829675f, 0.237137362f, 0.220673397f, 0.2053525f, 0.191095293f, 0.177827939f, 0.165481701f, 0.153992653f, 0.143301263f, 0.133352146f, 0.124093771f, 0.115478203f, 0.107460782f, 0.100000001f, 0.0930572003f, 0.0865964293f, 0.0805842131f, 0.0749894157f, 0.0697830543f, 0.0649381652f, 0.0604296438f, 0.0562341288f, 0.0523299128f, 0.0486967526f, 0.0453158356f, 0.0421696492f, 0.0392418988f, 0.0365174115f, 0.0339820832f, 0.0316227786f, 0.0294272732f, 0.0273841955f, 0.0254829675f, 0.0237137359f, 0.0220673401f, 0.0205352511f, 0.0191095304f, 0.0177827943f, 0.0165481716f, 0.0153992651f, 0.0143301254f, 0.0133352149f, 0.0124093769f, 0.0115478197f, 0.0107460786f, 0.00999999978f, 0.00930572022f, 0.00865964312f, 0.00805842225f, 0.00749894232f, 0.00697830599f, 0.00649381662f, 0.00604296429f, 0.00562341325f, 0.00523299119f, 0.00486967526f, 0.00453158375f, 0.00421696482f, 0.0039241896f, 0.00365174143f, 0.00339820841f, 0.00316227786f, 0.00294272718f, 0.00273841969f, 0.0025482967f, 0.00237137382f, 0.00220673415f, 0.00205352507f, 0.00191095285f, 0.00177827943f, 0.00165481714f, 0.00153992651f, 0.00143301266f, 0.00133352145f, 0.00124093785f, 0.00115478202f, 0.00107460783f, 0.00100000005f, 0.000930572103f, 0.000865964335f, 0.000805842225f, 0.000749894185f, 0.000697830576f, 0.000649381662f, 0.000604296394f, 0.000562341302f, 0.000523299095f, 0.000486967503f, 0.00045315834f, 0.000421696488f, 0.000392418995f, 0.000365174114f, 0.000339820806f, 0.000316227786f, 0.00029427273f, 0.000273841957f, 0.000254829676f, 0.000237137385f, 0.000220673421f, 0.000205352495f, 0.0001910953f, 0.00017782794f, 0.000165481717f, 0.000153992645f, 0.000143301266f, 0.00013335215f, 0.000124093771f, 0.000115478193f, 0.000107460779f};
__device__ __forceinline__ void p0_prologue(Frame& F) {
    unsigned* ctl = (unsigned*)(F.ws + WS_CTL);
    constexpr int NPUB = 18;
    if (F.vcu < NPUB) {
        const int row = F.vcu * NWAVES + F.wave;
        const float* c = row < 4 ? F.c_p + (size_t)row * D : F.c_s + (size_t)((row < NSEQ ? row : NSEQ - 1) - 4) * D;
        bf16* dst = WSP(bf16, WS_SILU) + (size_t)row * D;
#pragma unroll
        for (int j = 0; j < 4; ++j) { const int k = 8 * (F.lane + 64 * j);
            f32x4 c0 = *(const f32x4*)(c + k), c1 = *(const f32x4*)(c + k + 4);
            if (row >= NSEQ) { c0 = (f32x4){0.f, 0.f, 0.f, 0.f}; c1 = c0; }
            u32x4 p; p.x = pk2(silu_f(c0[0]), silu_f(c0[1])); p.y = pk2(silu_f(c0[2]), silu_f(c0[3])); p.z = pk2(silu_f(c1[0]), silu_f(c1[1])); p.w = pk2(silu_f(c1[2]), silu_f(c1[3]));
            *(u32x4*)(dst + k) = p; }
        VM_WAIT(); __syncthreads();
        if (F.tid == 0) { __builtin_amdgcn_fence(__ATOMIC_RELEASE, "agent"); VM_WAIT(); __hip_atomic_fetch_add(ctl + CW_SILU, 1u, __ATOMIC_RELAXED, __HIP_MEMORY_SCOPE_AGENT); }
    }
    LAS float* scr = (LAS float*)(F.lds + F.wave * 16384);
    if (F.mode == 2) {} else if (F.G == 256) { const int b = F.vcu; if (b >= 128) { const int start = (b - 128) * 128; transpose_range(F, start + F.wave, start + 128, NWAVES, scr); } }
    else transpose_range(F, F.vcu * NWAVES + F.wave, TR_P0_END, F.G * NWAVES, scr);
    float2* rope = WSP(float2, WS_ROPE);
    for (int idx = F.vcu * NTHREADS + F.tid; idx < 2056 * 128; idx += F.G * NTHREADS) {
        const int p = idx >> 7, i = idx & 127; const int pos = p < 2048 ? p : 16384 + (p - 2048);
        const float ang = (float)pos * ROPE_INV_FREQ[i];
        double t = (double)ang * 0.15915494309189535; t -= floor(t);
        const float f = (float)t;
        rope[idx] = make_float2(__builtin_amdgcn_cosf(f), __builtin_amdgcn_sinf(f)); }
#if defined(MK_STAMPS)
    if (F.tid == 0) ((unsigned long long*)(F.ws + ((size_t)901 << 20)) + (size_t)blockIdx.x * 64)[0] = __builtin_amdgcn_s_memrealtime();
#endif
    if (F.tid == 0) { unsigned sp = 0;
        while (__hip_atomic_load(ctl + CW_SILU, __ATOMIC_RELAXED, __HIP_MEMORY_SCOPE_AGENT) < (unsigned)(F.G < NPUB ? F.G : NPUB)) { __builtin_amdgcn_s_sleep(2); if (++sp > (1u << 22)) { atomicAdd(ctl + CW_BAR + XB_TMO, 1u); break; } }
        __builtin_amdgcn_fence(__ATOMIC_ACQUIRE, "agent"); VM_WAIT(); }
    __syncthreads();
#if defined(MK_STAMPS)
    unsigned long long* stq0 = (unsigned long long*)(F.ws + ((size_t)901 << 20)) + (size_t)blockIdx.x * 64;
    if (F.tid == 0) stq0[1] = __builtin_amdgcn_s_memrealtime();
    for (int it = F.vcu; it < 384; it += F.G) { ada_item(F, it); if (it == F.vcu && F.tid == 0) stq0[2] = __builtin_amdgcn_s_memrealtime(); }
#else
    if (F.mode != 1) for (int it = F.vcu; it < 384; it += F.G) ada_item(F, it);
#endif
}
template <int SRC, int NPARTS, bool XPF32>
__device__ __forceinline__ void norm_load_row(Frame& F, int lane, int r, f32x4 (&v)[8], const bf16* xcur_c, const void* xprev, const bf16* slab, const float* modl, int ig_prev, const float* pscale, bool& fixup) {
    fixup = false;
    if (SRC == 0) { const float* xr = r < MP ? F.x_p + (size_t)r * D : F.x_s + (size_t)(r - MP) * D;
#pragma unroll
        for (int j = 0; j < 8; ++j) v[j] = *(const f32x4*)(xr + 4 * (lane + 64 * j)); }
    else if (r < MP || NPARTS == 0) {
#pragma unroll
        for (int j = 0; j < 8; ++j) v[j] = ld_bf4(xcur_c + (size_t)r * D + 4 * (lane + 64 * j)); }
    else {
        fixup = true;
        const float* gate = modl + (size_t)seq_of(r) * NMOD + ig_prev * D;
#pragma unroll
        for (int j = 0; j < 8; ++j) { const int c = 4 * (lane + 64 * j);
            f32x4 sl[NPARTS > 0 ? NPARTS : 1];
#pragma unroll
            for (int p = 0; p < NPARTS; ++p) sl[p] = ld_bf4(slab + ((size_t)p * MS + (r - MP)) * D + c);
            const f32x4 xp = XPF32 ? *(const f32x4*)((const float*)xprev + (size_t)r * D + c) : ld_bf4((const bf16*)xprev + (size_t)r * D + c), gt = *(const f32x4*)(gate + c);
            f32x4 t = sl[0];
#pragma unroll
            for (int p = 1; p < NPARTS; ++p) t += sl[p];
            if (pscale) t *= *(const f32x4*)(pscale + c);
            v[j] = xp + gt * t;
            if ((j & 3) == 3) asm volatile("" ::: "memory"); }
    }
}
template <int SRC, int OUTMODE, int NPARTS, bool XPF32>
__device__ __forceinline__ void norm_rows(Frame& F, const bf16* xcur_c, bf16* xcur, const void* xprev, const bf16* slab, const float* modl, int ig_prev, const float* pscale,
                                          const float* g, int ish, int isc, bf16* A, float* yout) {
    const int gw = F.vcu * NWAVES + F.wave, NGW = F.G * NWAVES;
    int lane = F.lane; asm volatile("" : "+v"(lane));
    for (int r = gw; r < M; r += NGW) {
        const int s = seq_of(r);
        f32x4 v[8], gv[8], shv[8]; bool fix;
        norm_load_row<SRC, NPARTS, XPF32>(F, lane, r, v, xcur_c, xprev, slab, modl, ig_prev, pscale, fix);
        { const float* ms = modl + (size_t)s * NMOD;
#pragma unroll
          for (int j = 0; j < 8; ++j) { const int c = 4 * (lane + 64 * j);
              if (OUTMODE != 1) { const f32x4 gg = *(const f32x4*)(g + c), sc = *(const f32x4*)(ms + isc * D + c); gv[j] = gg * (sc + 1.0f); shv[j] = *(const f32x4*)(ms + ish * D + c); }
              else gv[j] = *(const f32x4*)(g + c); } }
        if (SRC == 1 && fix) {
#pragma unroll
            for (int j = 0; j < 8; ++j) { u32x2 w; w.x = pk2(v[j][0], v[j][1]); w.y = pk2(v[j][2], v[j][3]); *(u32x2*)(xcur + (size_t)r * D + 4 * (lane + 64 * j)) = w; } }
        float ss = 0.f;
#pragma unroll
        for (int j = 0; j < 8; ++j) ss += (v[j][0] * v[j][0] + v[j][1] * v[j][1]) + (v[j][2] * v[j][2] + v[j][3] * v[j][3]);
        const float rstd = 1.0f / sqrtf(wave_sum(ss) * (1.0f / D) + 1e-6f);
#pragma unroll
        for (int j = 0; j < 8; ++j) { const int c = 4 * (lane + 64 * j);
            f32x4 y = v[j] * rstd * gv[j];
            if (OUTMODE == 0 || OUTMODE == 2) {
                y = y + shv[j];
                if (OUTMODE == 0) { u32x2 w; w.x = pk2(y[0], y[1]); w.y = pk2(y[2], y[3]); *(u32x2*)(A + (size_t)r * D + c) = w; }
                else { y *= S_H2; *(unsigned*)((unsigned char*)A + (size_t)r * D + c) = pk4_fp8(y[0], y[1], y[2], y[3]); } }
            else *(f32x4*)(yout + (size_t)r * D + c) = y; }
    }
}
}
namespace pg8 {
using mk::bf16; using mk::bf16x8; using mk::f32x4; using mk::f32x2; using mk::u32x4; using mk::u32x2;
#define PG8_LAS __attribute__((address_space(3)))
constexpr int BM = 256, BK = 64, HALF = 128, HTB = HALF * BK * 2, STAGE_BYTES = 8 * HTB, NXCD = 8, WGM = 8;
__host__ __device__ __forceinline__ int lds_byte(int r, int c) { const int st = (r >> 4) * 2 + (c >> 5), rr = r & 15, cc = c & 31, ob = rr * 64 + cc * 2; return st * 1024 + (ob ^ (((ob >> 9) & 1) << 5)); }
__host__ __device__ __forceinline__ void stage_rc(int b, int& R, int& C) { const int st = b / 1024, sb = b % 1024, swz = sb ^ (((sb >> 9) & 1) << 5); R = (st >> 1) * 16 + swz / 64; C = (st & 1) * 32 + (swz % 64) / 2; }
__host__ __device__ __forceinline__ int perm32(int rho) { const int n = rho >> 4, i = rho & 15; return 8 * (i >> 2) + 4 * n + (i & 3); }

struct Unit { int pm, pn, ka, kb, nt, part; };
struct Gemm { const void* A; const void* Bt; int lda, ldb; };

struct OrdStatic {
    static constexpr bool HALF = false;
    int nM, nN, nwg, G, c, nt;
    __device__ void init(int M_, int N_, int Kbytes, int G_, int c_) { nM = M_ / BM; nN = N_ / BM; nwg = nM * nN; G = G_; c = c_; nt = Kbytes / 128; }
    __device__ __forceinline__ bool next(int i, Unit& u) const {
        const long L = (long)i * G + c; if (L >= nwg) return false;
        int wgid = (int)L; { const int q = nwg / NXCD, r = nwg % NXCD, xcd = wgid % NXCD, off = wgid / NXCD; wgid = (xcd < r ? xcd * (q + 1) : r * (q + 1) + (xcd - r) * q) + off; }
        const int nig = WGM * nN, gid = wgid / nig, fm = gid * WGM, gsz = (nM - fm) < WGM ? (nM - fm) : WGM;
        u.pm = fm + ((wgid % nig) % gsz); u.pn = (wgid % nig) / gsz; u.ka = 0; u.kb = 0; u.nt = nt; u.part = -1; return true;
    }
};
struct OrdStaticH {
    static constexpr bool HALF = true;
    OrdStatic o; int nfullr, nlast; bool split;
    __device__ void init(int M_, int N_, int Kbytes, int G_, int c_) { o.init(M_, N_, Kbytes, G_, c_); nfullr = o.nwg / G_; nlast = o.nwg % G_; split = 2 * nlast <= G_; }
    __device__ __forceinline__ int tail_first() const { return split ? 2 * nlast : nlast; }
    __device__ __forceinline__ bool next(int i, Unit& u) const {
        const bool last = split && i == nfullr;
        const int cc = last ? (o.c >> 1) : o.c;
        if (last ? (o.c >= 2 * nlast) : false) return false;
        OrdStatic t = o; t.c = cc;
        const bool ok = t.next(i, u);
        u.part = last ? -2 - (o.c & 1) : -1;
        return ok;
    }
};
struct OrdSplit {
    static constexpr bool HALF = false;
    int G, c, ntfull, nparts, pool;
    __device__ void init(int Kbytes, int nparts_, int pool_, int G_, int c_) { G = G_; c = c_; ntfull = Kbytes / 128; nparts = nparts_; pool = pool_; }
    __device__ __forceinline__ bool next(int i, Unit& u) const {
        int ii = i; if (G == 256 && 32 * nparts == 256 && ((c >> 3) & 1)) { if (i > 1) return false; ii = 1 - i; }
        const int L = ii * G + c; if (L >= 256 + 32 * nparts) return false;
        const bool full = L < 256;
        const int j = L - 256, un = j / nparts, p = j - un * nparts;
        const int pm = full ? (L & 7) * 4 + (L >> 6) : 32 + (un >> 3);
        const int pn = full ? ((L >> 3) & 7) : (un & 7);
        const int q = (ntfull / 2) / nparts, r = (ntfull / 2) % nparts;
        const int ntp = 2 * (q + (p < r ? 1 : 0)), t0 = 2 * (p * q + (p < r ? p : r));
        const int kb = full ? 0 : 128 * t0;
        u.pm = pm; u.pn = pn; u.part = full ? -1 : p; u.kb = kb; u.nt = full ? ntfull : ntp; u.ka = kb + (pool ? 1024 * (pn >> 1) : 0);
        return true;
    }
};

struct EpiProj {
    static constexpr bool PERM = true;
    bf16 *Q, *K, *V, *G; const float2* rope;
    __device__ __forceinline__ void operator()(const f32x4 (&acc)[2][2][4][2], const Unit& u, int wr, int wc, int fr, int fq) const {
        const int row0 = u.pm * BM + wr * 64 + fr, cw = wc * 32 + 8 * fq;
        if (u.pn < 16) {
            const int h = u.pn & 7; const bool isq = u.pn < 8;
            bf16* dst = (isq ? Q : K) + h * 256 + cw;
            const float lg2 = log2f(1.0f - exp2f(-5.0f - (float)h));
#pragma unroll
            for (int ai = 0; ai < 2; ++ai)
#pragma unroll
                for (int m = 0; m < 4; ++m) {
                    const int r = row0 + ai * HALF + m * 16;
                    const int p = r < mk::MP ? (r & 2047) : 2048 + ((r - mk::MP) & 7), nn = r < mk::MP ? (r & 127) : ((r - mk::MP) & 7);
                    const float sc = isq ? exp2f((float)nn * lg2) : exp2f(-(float)nn * lg2) * 0.0625f;
                    const f32x4* tp = (const f32x4*)(rope + (size_t)p * 128 + cw);
                    const f32x4 t0 = tp[0], t1 = tp[1], t2 = tp[2], t3 = tp[3];
                    const f32x4 a0 = acc[ai][0][m][0], a1 = acc[ai][0][m][1], b0 = acc[ai][1][m][0], b1 = acc[ai][1][m][1];
                    f32x4 lo0, lo1, hi0, hi1;
                    lo0[0] = a0[0] * t0[0] - b0[0] * t0[1]; hi0[0] = a0[0] * t0[1] + b0[0] * t0[0];
                    lo0[1] = a0[1] * t0[2] - b0[1] * t0[3]; hi0[1] = a0[1] * t0[3] + b0[1] * t0[2];
                    lo0[2] = a0[2] * t1[0] - b0[2] * t1[1]; hi0[2] = a0[2] * t1[1] + b0[2] * t1[0];
                    lo0[3] = a0[3] * t1[2] - b0[3] * t1[3]; hi0[3] = a0[3] * t1[3] + b0[3] * t1[2];
                    lo1[0] = a1[0] * t2[0] - b1[0] * t2[1]; hi1[0] = a1[0] * t2[1] + b1[0] * t2[0];
                    lo1[1] = a1[1] * t2[2] - b1[1] * t2[3]; hi1[1] = a1[1] * t2[3] + b1[1] * t2[2];
                    lo1[2] = a1[2] * t3[0] - b1[2] * t3[1]; hi1[2] = a1[2] * t3[1] + b1[2] * t3[0];
                    lo1[3] = a1[3] * t3[2] - b1[3] * t3[3]; hi1[3] = a1[3] * t3[3] + b1[3] * t3[2];
                    lo0 *= sc; lo1 *= sc; hi0 *= sc; hi1 *= sc;
                    u32x4 w; w.x = mk::pk2(lo0[0], lo0[1]); w.y = mk::pk2(lo0[2], lo0[3]); w.z = mk::pk2(lo1[0], lo1[1]); w.w = mk::pk2(lo1[2], lo1[3]);
                    *(u32x4*)(dst + (size_t)r * 2048) = w;
                    w.x = mk::pk2(hi0[0], hi0[1]); w.y = mk::pk2(hi0[2], hi0[3]); w.z = mk::pk2(hi1[0], hi1[1]); w.w = mk::pk2(hi1[2], hi1[3]);
                    *(u32x4*)(dst + (size_t)r * 2048 + 128) = w;
                }
        } else {
            const bool isv = u.pn < 32;
            bf16* dst = (isv ? V + (u.pn - 16) * 256 : G + (u.pn - 32) * 256) + cw;
#pragma unroll
            for (int ai = 0; ai < 2; ++ai)
#pragma unroll
                for (int m = 0; m < 4; ++m) { bf16* rowp = dst + (size_t)(row0 + ai * HALF + m * 16) * 4096;
                    float e[16];
                    if (!isv) {
#pragma unroll
                        for (int q = 0; q < 16; ++q) e[q] = __builtin_amdgcn_exp2f(-1.44269504089f * acc[ai][q >> 3][m][(q >> 2) & 1][q & 3]);
                        asm volatile("" : "+v"(e[0]), "+v"(e[1]), "+v"(e[2]), "+v"(e[3]), "+v"(e[4]), "+v"(e[5]), "+v"(e[6]), "+v"(e[7]), "+v"(e[8]), "+v"(e[9]), "+v"(e[10]), "+v"(e[11]), "+v"(e[12]), "+v"(e[13]), "+v"(e[14]), "+v"(e[15]));
#pragma unroll
                        for (int q = 0; q < 16; ++q) e[q] = __builtin_amdgcn_rcpf(1.0f + e[q]);
                        asm volatile("" : "+v"(e[0]), "+v"(e[1]), "+v"(e[2]), "+v"(e[3]), "+v"(e[4]), "+v"(e[5]), "+v"(e[6]), "+v"(e[7]), "+v"(e[8]), "+v"(e[9]), "+v"(e[10]), "+v"(e[11]), "+v"(e[12]), "+v"(e[13]), "+v"(e[14]), "+v"(e[15])); }
#pragma unroll
                    for (int bj = 0; bj < 2; ++bj) { f32x4 v0 = acc[ai][bj][m][0], v1 = acc[ai][bj][m][1];
                        if (!isv) {
#pragma unroll
                            for (int j = 0; j < 4; ++j) { v0[j] *= e[8 * bj + j]; v1[j] *= e[8 * bj + 4 + j]; } }
                        u32x4 w; w.x = mk::pk2(v0[0], v0[1]); w.y = mk::pk2(v0[2], v0[3]); w.z = mk::pk2(v1[0], v1[1]); w.w = mk::pk2(v1[2], v1[3]);
                        *(u32x4*)(rowp + bj * HALF) = w; } }
        }
    }
};
template <bool F8> struct EpiSwiglu {
    static constexpr bool PERM = true;
    void* H;
#if MK_EXPERIMENT
    int xmode;
#endif
    __device__ __forceinline__ void operator()(const f32x4 (&acc)[2][2][4][2], const Unit& u, int wr, int wc, int fr, int fq) const {
#if MK_EXPERIMENT
        if (xmode == 6) return;
#endif
        const int row0 = u.pm * BM + (u.part == -3 ? HALF : 0) + wr * 64 + fr; const int col = u.pn * 128 + wc * 32 + 8 * fq;
        const float si = F8 ? 1.0f / (mk::S_H2 * mk::S_W1) : 1.0f;
#pragma unroll
        for (int ai = 0; ai < 2; ++ai) if (ai == 0 || u.part >= -1)
#pragma unroll
            for (int mp = 0; mp < 2; ++mp) { float gg[16], uu[16], e[16];
#pragma unroll
                for (int q = 0; q < 16; ++q) { const int m = 2 * mp + (q >> 3), n = (q >> 2) & 1, j = q & 3; gg[q] = acc[ai][0][m][n][j] * si; uu[q] = acc[ai][1][m][n][j] * si; }
#if MK_EXPERIMENT
                if (xmode == 5) {
#pragma unroll
                    for (int q = 0; q < 16; ++q) e[q] = 1.0f; } else
#endif
                {
#pragma unroll
                for (int q = 0; q < 16; ++q) e[q] = __builtin_amdgcn_exp2f(-1.44269504089f * gg[q]);
                asm volatile("" : "+v"(e[0]), "+v"(e[1]), "+v"(e[2]), "+v"(e[3]), "+v"(e[4]), "+v"(e[5]), "+v"(e[6]), "+v"(e[7]), "+v"(e[8]), "+v"(e[9]), "+v"(e[10]), "+v"(e[11]), "+v"(e[12]), "+v"(e[13]), "+v"(e[14]), "+v"(e[15]));
#pragma unroll
                for (int q = 0; q < 16; ++q) e[q] = __builtin_amdgcn_rcpf(1.0f + e[q]);
                asm volatile("" : "+v"(e[0]), "+v"(e[1]), "+v"(e[2]), "+v"(e[3]), "+v"(e[4]), "+v"(e[5]), "+v"(e[6]), "+v"(e[7]), "+v"(e[8]), "+v"(e[9]), "+v"(e[10]), "+v"(e[11]), "+v"(e[12]), "+v"(e[13]), "+v"(e[14]), "+v"(e[15])); }
#pragma unroll
                for (int mm = 0; mm < 2; ++mm) { const int m = 2 * mp + mm; f32x4 v0, v1;
#pragma unroll
                    for (int j = 0; j < 4; ++j) { v0[j] = gg[8 * mm + j] * e[8 * mm + j] * uu[8 * mm + j]; v1[j] = gg[8 * mm + 4 + j] * e[8 * mm + 4 + j] * uu[8 * mm + 4 + j]; }
                    const size_t off = (size_t)(row0 + ai * HALF + m * 16) * mk::FF + col;
                    if (F8) { v0 *= mk::S_HID; v1 *= mk::S_HID; u32x2 w; w.x = mk::pk4_fp8(v0[0], v0[1], v0[2], v0[3]); w.y = mk::pk4_fp8(v1[0], v1[1], v1[2], v1[3]);
#if MK_EXPERIMENT
                        if (xmode == 4 && (w.x ^ w.y) != 0x13572468u) continue;
#endif
                        *(u32x2*)((unsigned char*)H + off) = w; }
                    else { u32x4 w; w.x = mk::pk2(v0[0], v0[1]); w.y = mk::pk2(v0[2], v0[3]); w.z = mk::pk2(v1[0], v1[1]); w.w = mk::pk2(v1[2], v1[3]); *(u32x4*)((bf16*)H + off) = w; } } }
    }
};
template <int MODE, bool XIF32> struct EpiResid {
    static constexpr bool PERM = true;
    const void* xi; bf16* xo; const float* gate  ; bf16* slab; float* extra; float ascale  ;
    __device__ __forceinline__ void operator()(const f32x4 (&acc)[2][2][4][2], const Unit& u, int wr, int wc, int fr, int fq) const {
        const int row0 = u.pm * BM + wr * 64 + fr, col0 = u.pn * BM + wc * 32 + 8 * fq;
        if (u.part >= 0) {
            bf16* sp = slab + ((ptrdiff_t)u.part * mk::MS - mk::MP) * (ptrdiff_t)mk::D + col0;
#pragma unroll
            for (int ai = 0; ai < 2; ++ai)
#pragma unroll
                for (int m = 0; m < 4; ++m) { bf16* rowp = sp + (ptrdiff_t)(row0 + ai * HALF + m * 16) * mk::D;
#pragma unroll
                    for (int bj = 0; bj < 2; ++bj) { const f32x4 v0 = acc[ai][bj][m][0] * ascale, v1 = acc[ai][bj][m][1] * ascale;
                        u32x4 w; w.x = mk::pk2(v0[0], v0[1]); w.y = mk::pk2(v0[2], v0[3]); w.z = mk::pk2(v1[0], v1[1]); w.w = mk::pk2(v1[2], v1[3]); *(u32x4*)(rowp + bj * HALF) = w; } }
            return;
        }
#pragma unroll
        for (int ai = 0; ai < 2; ++ai)
#pragma unroll
            for (int m = 0; m < 4; ++m) { const int r = row0 + ai * HALF + m * 16; const size_t off = (size_t)r * mk::D + col0; const float* gp = gate + (size_t)mk::seq_of(r) * mk::NMOD + col0;
                float ss = 0.f;
#pragma unroll
                for (int bj = 0; bj < 2; ++bj) { const int o = bj * HALF;
                    f32x4 x0, x1;
                    if constexpr (XIF32) { x0 = *(const f32x4*)((const float*)xi + off + o); x1 = *(const f32x4*)((const float*)xi + off + o + 4); }
                    else { const u32x4 w = *(const u32x4*)((const bf16*)xi + off + o);
                        x0 = (f32x4){__uint_as_float(w.x << 16), __uint_as_float(w.x & 0xffff0000u), __uint_as_float(w.y << 16), __uint_as_float(w.y & 0xffff0000u)};
                        x1 = (f32x4){__uint_as_float(w.z << 16), __uint_as_float(w.z & 0xffff0000u), __uint_as_float(w.w << 16), __uint_as_float(w.w & 0xffff0000u)}; }
                    f32x4 v0 = acc[ai][bj][m][0] * ascale, v1 = acc[ai][bj][m][1] * ascale;
                    if constexpr (MODE == 1) { v0 *= *(const f32x4*)(extra + col0 + o); v1 *= *(const f32x4*)(extra + col0 + o + 4); }
                    const f32x4 y0 = x0 + *(const f32x4*)(gp + o) * v0, y1 = x1 + *(const f32x4*)(gp + o + 4) * v1;
                    u32x4 w; w.x = mk::pk2(y0[0], y0[1]); w.y = mk::pk2(y0[2], y0[3]); w.z = mk::pk2(y1[0], y1[1]); w.w = mk::pk2(y1[2], y1[3]); *(u32x4*)(xo + off + o) = w;
                    if constexpr (MODE == 2) ss += ((y0[0] * y0[0] + y0[1] * y0[1]) + (y0[2] * y0[2] + y0[3] * y0[3])) + ((y1[0] * y1[0] + y1[1] * y1[1]) + (y1[2] * y1[2] + y1[3] * y1[3])); }
                if constexpr (MODE == 2) { ss += __shfl_xor(ss, 16); ss += __shfl_xor(ss, 32); if (fq == 0) __hip_atomic_fetch_add(extra + r, ss, __ATOMIC_RELAXED, __HIP_MEMORY_SCOPE_AGENT); }
                asm volatile("" ::: "memory"); }
    }
};

typedef int i32x4 __attribute__((ext_vector_type(4)));
typedef int i32x8 __attribute__((ext_vector_type(8)));
template <bool F8> struct FragT;
template <> struct FragT<false> { bf16x8 k0, k1; };
template <> struct FragT<true>  { i32x8 v; };
template <bool F8> __device__ __forceinline__ void frag_load(FragT<F8>& f, const PG8_LAS unsigned char* p) {
    if constexpr (F8) { f.v.lo = *(const PG8_LAS i32x4*)p; f.v.hi = *(const PG8_LAS i32x4*)(p + 1024); }
    else { f.k0 = *(const PG8_LAS bf16x8*)p; f.k1 = *(const PG8_LAS bf16x8*)(p + 1024); }
}
template <bool F8> __device__ __forceinline__ void frag_mma(f32x4& acc, const FragT<F8>& b, const FragT<F8>& a) {
    if constexpr (F8) {
        const int sc = 0x7F7F7F7F;
#if defined(__HIP_DEVICE_COMPILE__)
        asm volatile("v_mfma_scale_f32_16x16x128_f8f6f4 %0, %1, %2, %0, %3, %3 op_sel_hi:[0,0,0]" : "+v"(acc) : "v"(b.v), "v"(a.v), "v"(sc));
#else
        (void)sc;
#endif
    }
    else { acc = __builtin_amdgcn_mfma_f32_16x16x32_bf16(b.k0, a.k0, acc, 0, 0, 0); acc = __builtin_amdgcn_mfma_f32_16x16x32_bf16(b.k1, a.k1, acc, 0, 0, 0); }
}
template <bool F8, class Epi, class Sched>
__device__ __forceinline__ void gemm_phase(PG8_LAS unsigned char* lds, const Gemm g, const Sched& S, const Epi& E
#if defined(MK_STAMPS)
    , unsigned long long* stq = nullptr
#endif
    ) {
#if defined(MK_STAMPS)
    unsigned long long st_kl = 0, st_epi = 0, st_a = 0, st_b = 0, st_eo = 0; unsigned st_nt = 0, st_nu = 0;
#endif
    const int tid = threadIdx.x, wid = __builtin_amdgcn_readfirstlane(tid >> 6), lane = tid & 63, wr = wid >> 2, wc = wid & 3, fr = lane & 15, fq = lane >> 4;
    unsigned voffA[2], voffB[2];
#pragma unroll
    for (int i = 0; i < 2; ++i) { int R, C; stage_rc(tid * 16 + i * 8192, R, C); const int Rb = Epi::PERM ? ((R & ~31) + perm32(R & 31)) : R;
        voffA[i] = (unsigned)(R * g.lda + C * 2); voffB[i] = (unsigned)(Rb * g.ldb + C * 2); }
    const size_t kstep = (size_t)(BK * 2);
    const size_t hstepA = (size_t)HALF * g.lda, hstepB = (size_t)HALF * g.ldb;
    const unsigned ldsw = (unsigned)wid * 1024u;
    const int aoff = lds_byte(wr * 64 + fr, fq * 8), boff = lds_byte(wc * 32 + fr, fq * 8);
#define PG8_SA(b, h) (((b) * 2 + (h)) * HTB)
#define PG8_SB(b, h) ((4 + (b) * 2 + (h)) * HTB)
#define PG8_STAGE(bufoff, gbase, voff) do { _Pragma("unroll") for (int _i = 0; _i < 2; ++_i) \
        __builtin_amdgcn_global_load_lds((const unsigned*)((const char*)(gbase) + (voff)[_i]), (PG8_LAS unsigned*)(lds + (bufoff) + ldsw + _i * 8192), 16, 0, 0); } while (0)
#define PG8_LDA(dst, b, h) do { _Pragma("unroll") for (int m = 0; m < 4; ++m) frag_load<F8>(dst[m], lds + PG8_SA(b, h) + aoff + m * 2048); } while (0)
#define PG8_LDB(dst, b, h) do { _Pragma("unroll") for (int n = 0; n < 2; ++n) frag_load<F8>(dst[n], lds + PG8_SB(b, h) + boff + n * 2048); } while (0)
#define PG8_MMA(ai, bj, At, Bt) do { __builtin_amdgcn_s_setprio(1); _Pragma("unroll") for (int m = 0; m < 4; ++m) _Pragma("unroll") for (int n = 0; n < 2; ++n) frag_mma<F8>(acc[ai][bj][m][n], Bt[n], At[m]); \
        __builtin_amdgcn_s_setprio(0); } while (0)
#define PG8_WAIT_V(n) asm volatile("s_waitcnt vmcnt(" #n ")" ::: "memory")
#define PG8_WAIT_L(n) asm volatile("s_waitcnt lgkmcnt(" #n ")" ::: "memory")
#define PG8_BAR __builtin_amdgcn_s_barrier()
#define PG8_SCHED __builtin_amdgcn_sched_barrier(0)
    Unit cur, nxt; int ui = 0;
    if (!S.next(0, cur)) return;
    f32x4 acc[2][2][4][2];
#pragma unroll
    for (int a = 0; a < 2; ++a)
#pragma unroll
        for (int b = 0; b < 2; ++b)
#pragma unroll
            for (int m = 0; m < 4; ++m)
#pragma unroll
                for (int n = 0; n < 2; ++n) acc[a][b][m][n] = (f32x4){0.f, 0.f, 0.f, 0.f};
    FragT<F8> At[4], B0[2], B1[2];
    const char* cA = (const char*)g.A + (size_t)(cur.pm * 2 + (Sched::HALF && cur.part == -3 ? 1 : 0)) * hstepA + (size_t)cur.ka; const char* cB = (const char*)g.Bt + (size_t)cur.pn * 2 * hstepB + (size_t)cur.kb;
    PG8_STAGE(PG8_SB(0, 0), cB, voffB); PG8_STAGE(PG8_SB(0, 1), cB + hstepB, voffB); PG8_STAGE(PG8_SA(0, 0), cA, voffA); PG8_STAGE(PG8_SA(0, 1), cA + hstepA, voffA);
    if (wr == 1) PG8_BAR;
    PG8_WAIT_V(2); PG8_BAR;
    PG8_STAGE(PG8_SB(1, 0), cB + kstep, voffB); PG8_STAGE(PG8_SA(1, 0), cA + kstep, voffA); PG8_STAGE(PG8_SB(1, 1), cB + hstepB + kstep, voffB);
    PG8_WAIT_V(6); PG8_BAR;
    for (;;) {
        const bool has_next = S.next(ui + 1, nxt);
        const char* nA = has_next ? (const char*)g.A + (size_t)(nxt.pm * 2 + (Sched::HALF && nxt.part == -3 ? 1 : 0)) * hstepA + (size_t)nxt.ka : cA; const char* nB = has_next ? (const char*)g.Bt + (size_t)nxt.pn * 2 * hstepB + (size_t)nxt.kb : cB;
        const int nt = cur.nt;
        const bool hf = Sched::HALF && cur.part < -1;
#if defined(MK_STAMPS)
        st_a = __builtin_amdgcn_s_memrealtime(); if (st_nu) st_epi += st_a - st_b;
#endif
        for (int t = 0; t < nt; t += 2) {
            const bool last = (t == nt - 2);
            const char* a1 = cA + (size_t)(t + 1) * kstep;
            const char* a2 = last ? nA : cA + (size_t)(t + 2) * kstep; const char* b2 = last ? nB : cB + (size_t)(t + 2) * kstep;
            const char* a3 = a2 + kstep; const char* b3 = b2 + kstep;
            PG8_LDB(B0, 0, 0); PG8_LDB(B1, 0, 1); PG8_SCHED; PG8_LDA(At, 0, 0); PG8_STAGE(PG8_SA(1, 1), a1 + hstepA, voffA);
            PG8_WAIT_V(8); PG8_WAIT_L(0); PG8_BAR; PG8_MMA(0, 0, At, B0); PG8_MMA(0, 1, At, B1); PG8_BAR; PG8_SCHED;
            if (!hf) PG8_LDA(At, 0, 1); PG8_STAGE(PG8_SB(0, 0), b2, voffB); PG8_STAGE(PG8_SB(0, 1), b2 + hstepB, voffB); PG8_STAGE(PG8_SA(0, 0), a2, voffA);
            PG8_WAIT_V(8); PG8_WAIT_L(0); PG8_BAR; if (!hf) { PG8_MMA(1, 0, At, B0); PG8_MMA(1, 1, At, B1); } PG8_BAR; PG8_SCHED;
            PG8_LDB(B0, 1, 0); PG8_LDB(B1, 1, 1); PG8_SCHED; PG8_LDA(At, 1, 0); PG8_STAGE(PG8_SA(0, 1), a2 + hstepA, voffA);
            PG8_WAIT_V(8); PG8_WAIT_L(0); PG8_BAR; PG8_MMA(0, 0, At, B0); PG8_MMA(0, 1, At, B1); PG8_BAR; PG8_SCHED;
            if (!hf) PG8_LDA(At, 1, 1); PG8_STAGE(PG8_SB(1, 0), b3, voffB); PG8_STAGE(PG8_SB(1, 1), b3 + hstepB, voffB); PG8_STAGE(PG8_SA(1, 0), a3, voffA);
            PG8_WAIT_V(8); PG8_WAIT_L(0); PG8_BAR; if (!hf) { PG8_MMA(1, 0, At, B0); PG8_MMA(1, 1, At, B1); } PG8_BAR; PG8_SCHED;
        }
#if defined(MK_STAMPS)
        st_b = __builtin_amdgcn_s_memrealtime(); st_kl += st_b - st_a; st_nt += (unsigned)nt; ++st_nu;
#endif
        if (wr == 0) PG8_BAR;
        if constexpr (F8) asm volatile("s_nop 15\n\ts_nop 15" ::: "memory");
#if defined(MK_STAMPS)
        const unsigned long long st_e0 = __builtin_amdgcn_s_memrealtime();
#endif
        E(acc, cur, wr, wc, fr, fq);
#if defined(MK_STAMPS)
        __builtin_amdgcn_sched_barrier(0); st_eo += __builtin_amdgcn_s_memrealtime() - st_e0;
#endif
        if (!has_next) break;
#pragma unroll
        for (int a = 0; a < 2; ++a)
#pragma unroll
            for (int b = 0; b < 2; ++b)
#pragma unroll
                for (int m = 0; m < 4; ++m)
#pragma unroll
                    for (int n = 0; n < 2; ++n) acc[a][b][m][n] = (f32x4){0.f, 0.f, 0.f, 0.f};
        cur = nxt; cA = nA; cB = nB; ++ui;
        if (wr == 1) PG8_BAR;
    }
#if defined(MK_STAMPS)
    st_epi += __builtin_amdgcn_s_memrealtime() - st_b;
    if (stq && tid == 0) { stq[0] = st_kl; stq[1] = st_epi; stq[2] = st_nt; stq[3] = (unsigned long long)st_nu | (st_eo << 8); }
#endif
    PG8_WAIT_V(0);
    PG8_BAR;
#undef PG8_SA
#undef PG8_SB
#undef PG8_STAGE
#undef PG8_LDA
#undef PG8_LDB
#undef PG8_MMA
#undef PG8_WAIT_V
#undef PG8_WAIT_L
#undef PG8_BAR
#undef PG8_SCHED
}
}
namespace mk {
__device__ __forceinline__ s16x4 tr16(const LAS unsigned char* p) { return __builtin_bit_cast(s16x4, __builtin_amdgcn_ds_read_tr16_b64_v4i16((LAS v4i16_t*)p)); }
__device__ __forceinline__ bf16x8 cat8(s16x4 lo, s16x4 hi) { return __builtin_shufflevector(lo, hi, 0, 1, 2, 3, 4, 5, 6, 7); }
#define LBAR() do { asm volatile("s_waitcnt lgkmcnt(0)" ::: "memory"); __builtin_amdgcn_s_barrier(); asm volatile("" ::: "memory"); } while (0)

constexpr int KT_OFF = 0, KT_ROW = 544, VT_OFF = 128 * KT_ROW  , VT_ROW = 160, SD_OFF = VT_OFF + 128 * VT_ROW  , SD_ROW = 160;
static_assert(SD_OFF + 256 * SD_ROW == 131072, "retention LDS map");

__device__ __forceinline__ void ret_prompt_item(Frame& F, int item) {
    const int b = item >> 6, h = (item >> 3) & 7, sl = item & 7;
    const int w = F.wave, lane = F.lane, fr = lane & 15, fq = lane >> 4, tq = (lane & 15) >> 2, tp = lane & 3;
    const int ns = w < 4 ? w : 11 - w;
    const float gam = 1.0f - exp2f(-5.0f - (float)h);
    const float g127 = exp2f(127.0f * log2f(gam));
    const bf16* Qg = WSP(bf16, WS_Q) + (size_t)(b * 2048) * D + h * DK;
    const bf16* Kg = WSP(bf16, WS_K) + (size_t)(b * 2048) * D + h * DK;
    const bf16* Vg = WSP(bf16, WS_V) + (size_t)(b * 2048) * HV + h * DV + sl * 64;
    bf16* Og = WSP(bf16, WS_O) + (size_t)(b * 2048) * HV + h * DV + sl * 64;
    LAS unsigned char* lds = F.lds;
    f32x4 sacc[4][2];
#pragma unroll
    for (int a = 0; a < 4; ++a)
#pragma unroll
        for (int d = 0; d < 2; ++d) sacc[a][d] = (f32x4){0.f, 0.f, 0.f, 0.f};
    u32x4 kreg[8], vreg[2];
#pragma unroll
    for (int i = 0; i < 8; ++i) { const int idx = F.tid + 512 * i, row = idx >> 5, c16 = idx & 31; kreg[i] = *(const u32x4*)(Kg + (size_t)row * D + 8 * c16); }
#pragma unroll
    for (int i = 0; i < 2; ++i) { const int idx = F.tid + 512 * i, row = idx >> 3, c16 = idx & 7; vreg[i] = *(const u32x4*)(Vg + (size_t)row * HV + 8 * c16); }
    LBAR();
#pragma unroll
    for (int i = 0; i < 8; ++i) { const int idx = F.tid + 512 * i, row = idx >> 5, c16 = idx & 31; *(LAS u32x4*)(lds + KT_OFF + row * KT_ROW + c16 * 16) = kreg[i]; }
#pragma unroll
    for (int i = 0; i < 2; ++i) { const int idx = F.tid + 512 * i, row = idx >> 3, c16 = idx & 7; *(LAS u32x4*)(lds + VT_OFF + row * VT_ROW + c16 * 16) = vreg[i]; }
    for (int c = 0; c < 16; ++c) {
        const int t0 = 128 * c;
        bf16x8 qf[8];
        { const bf16* qp = Qg + (size_t)(t0 + 16 * ns + fr) * D + 8 * fq;
#pragma unroll
          for (int ks = 0; ks < 8; ++ks) qf[ks] = *(const bf16x8*)(qp + 32 * ks); }
        LBAR();
        { const int cn = c + 1 < 16 ? c + 1 : c; const bf16* kp = Kg + (size_t)(128 * cn) * D; const bf16* vp = Vg + (size_t)(128 * cn) * HV;
#pragma unroll
          for (int i = 0; i < 8; ++i) { const int idx = F.tid + 512 * i, row = idx >> 5, c16 = idx & 31; kreg[i] = *(const u32x4*)(kp + (size_t)row * D + 8 * c16); }
#pragma unroll
          for (int i = 0; i < 2; ++i) { const int idx = F.tid + 512 * i, row = idx >> 3, c16 = idx & 7; vreg[i] = *(const u32x4*)(vp + (size_t)row * HV + 8 * c16); } }
#pragma unroll
        for (int a = 0; a < 4; ++a)
#pragma unroll
            for (int d = 0; d < 2; ++d) sacc[a][d] *= gam;
#pragma unroll
        for (int ks = 0; ks < 4; ++ks) {
            bf16x8 bk[2];
#pragma unroll
            for (int dt = 0; dt < 2; ++dt) { const LAS unsigned char* p = lds + KT_OFF + (32 * ks + 4 * fq + tq) * KT_ROW + (32 * w + 16 * dt + 4 * tp) * 2; bk[dt] = cat8(tr16(p), tr16(p + 16 * KT_ROW)); }
#pragma unroll
            for (int et = 0; et < 4; ++et) {
                const LAS unsigned char* p = lds + VT_OFF + (32 * ks + 4 * fq + tq) * VT_ROW + (16 * et + 4 * tp) * 2;
                const bf16x8 a = cat8(tr16(p), tr16(p + 16 * VT_ROW));
#pragma unroll
                for (int dt = 0; dt < 2; ++dt) sacc[et][dt] = __builtin_amdgcn_mfma_f32_16x16x32_bf16(a, bk[dt], sacc[et][dt], 0, 0, 0);
            }
        }
#pragma unroll
        for (int a = 0; a < 4; ++a)
#pragma unroll
            for (int d = 0; d < 2; ++d) sacc[a][d] *= g127;
        f32x4 oacc[4];
#pragma unroll
        for (int et = 0; et < 4; ++et) oacc[et] = (f32x4){0.f, 0.f, 0.f, 0.f};
        if (c > 0) {
#pragma unroll
            for (int ks = 0; ks < 8; ++ks)
#pragma unroll
                for (int et = 0; et < 4; ++et) {
                    const LAS unsigned char* p = lds + SD_OFF + (32 * ks + 8 * fq + tq) * SD_ROW + (16 * et + 4 * tp) * 2;
                    const bf16x8 a = cat8(tr16(p), tr16(p + 4 * SD_ROW));
                    oacc[et] = __builtin_amdgcn_mfma_f32_16x16x32_bf16(a, qf[ks], oacc[et], 0, 0, 0);
                }
#pragma unroll
            for (int et = 0; et < 4; ++et) oacc[et] *= gam;
        }
        for (int u2 = 0; 2 * u2 <= ns; ++u2) {
            const int mt0 = 2 * u2, mt1 = 2 * u2 + 1;
            f32x4 st0 = (f32x4){0.f, 0.f, 0.f, 0.f}, st1 = st0;
            { const LAS unsigned char* ka = lds + KT_OFF + (16 * mt0 + fr) * KT_ROW + 16 * fq;
#pragma unroll
              for (int ks = 0; ks < 8; ++ks) { const bf16x8 a = *(const LAS bf16x8*)(ka + 64 * ks); st0 = __builtin_amdgcn_mfma_f32_16x16x32_bf16(a, qf[ks], st0, 0, 0, 0); } }
            if (mt1 <= ns) { const LAS unsigned char* ka = lds + KT_OFF + (16 * mt1 + fr) * KT_ROW + 16 * fq;
#pragma unroll
              for (int ks = 0; ks < 8; ++ks) { const bf16x8 a = *(const LAS bf16x8*)(ka + 64 * ks); st1 = __builtin_amdgcn_mfma_f32_16x16x32_bf16(a, qf[ks], st1, 0, 0, 0); } }
#pragma unroll
            for (int j = 0; j < 4; ++j) { if (mt0 == ns && 4 * fq + j > fr) st0[j] = 0.f; if (mt1 > ns || (mt1 == ns && 4 * fq + j > fr)) st1[j] = 0.f; }
            u32x4 pp; pp.x = pk2(st0[0], st0[1]); pp.y = pk2(st0[2], st0[3]); pp.z = pk2(st1[0], st1[1]); pp.w = pk2(st1[2], st1[3]);
            const bf16x8 pb = __builtin_bit_cast(bf16x8, pp);
#pragma unroll
            for (int et = 0; et < 4; ++et) {
                const LAS unsigned char* p = lds + VT_OFF + (16 * mt0 + 4 * fq + tq) * VT_ROW + (16 * et + 4 * tp) * 2;
                const bf16x8 a = cat8(tr16(p), tr16(p + 16 * VT_ROW));
                oacc[et] = __builtin_amdgcn_mfma_f32_16x16x32_bf16(a, pb, oacc[et], 0, 0, 0);
            }
        }
        { bf16* op = Og + (size_t)(t0 + 16 * ns + fr) * HV + 4 * fq;
#pragma unroll
          for (int et = 0; et < 4; ++et) { u32x2 o2; o2.x = pk2(oacc[et][0], oacc[et][1]); o2.y = pk2(oacc[et][2], oacc[et][3]); *(u32x2*)(op + 16 * et) = o2; } }
        LBAR();
#pragma unroll
        for (int et = 0; et < 4; ++et)
#pragma unroll
            for (int dt = 0; dt < 2; ++dt) { u32x2 o2; o2.x = pk2(sacc[et][dt][0], sacc[et][dt][1]); o2.y = pk2(sacc[et][dt][2], sacc[et][dt][3]);
                *(LAS u32x2*)(lds + SD_OFF + (32 * w + 16 * dt + fr) * SD_ROW + (16 * et + 4 * fq) * 2) = o2; }
#pragma unroll
        for (int i = 0; i < 8; ++i) { const int idx = F.tid + 512 * i, row = idx >> 5, c16 = idx & 31; *(LAS u32x4*)(lds + KT_OFF + row * KT_ROW + c16 * 16) = kreg[i]; }
#pragma unroll
        for (int i = 0; i < 2; ++i) { const int idx = F.tid + 512 * i, row = idx >> 3, c16 = idx & 7; *(LAS u32x4*)(lds + VT_OFF + row * VT_ROW + c16 * 16) = vreg[i]; }
    }
    { float* sp = F.sr_p + ((size_t)(b * NH + h) * DK) * DV + sl * 64;
#pragma unroll
      for (int et = 0; et < 4; ++et)
#pragma unroll
          for (int dt = 0; dt < 2; ++dt) *(f32x4*)(sp + (size_t)(32 * w + 16 * dt + fr) * DV + 16 * et + 4 * fq) = sacc[et][dt]; }
    LBAR();
}

constexpr int SQ_OFF = 0, SK_OFF = 8 * 260 * 4, SV_OFF = SK_OFF + 256 * 8 * 4, SPART_OFF = SV_OFF + 8 * 512 * 4, SPM_OFF = SPART_OFF + 512 * 4;
__device__ __forceinline__ void ret_sample_item(Frame& F, int item) {
    const int b = item >> 3, h = item & 7, w = F.wave, lane = F.lane, fr = lane & 15, fq = lane >> 4, tid = F.tid;
    const float gam = 1.0f - exp2f(-5.0f - (float)h);
    const float g7 = exp2f(7.0f * log2f(gam)), g8 = g7 * gam;
    const int r0 = MP + 8 * b;
    LAS float* qs = (LAS float*)(F.lds + SQ_OFF); LAS float* kt = (LAS float*)(F.lds + SK_OFF); LAS float* vs = (LAS float*)(F.lds + SV_OFF);
    LAS float* part = (LAS float*)(F.lds + SPART_OFF); LAS float* pm = (LAS float*)(F.lds + SPM_OFF);
    const int e4 = 64 * w + 4 * fr;
    const float* S0 = F.state_ret + ((size_t)(b * NH + h) * DK + fq) * DV + e4;
    float* S1 = F.sr_s + ((size_t)(b * NH + h) * DK + fq) * DV + e4;
    f32x4 sa[8], sb[8];
    const int tq8 = (tid & 255) >> 5, d0 = 8 * (tid & 31); const bool isq = tid < 256;
    const u32x4 rawqk = *(const u32x4*)((isq ? WSP(bf16, WS_Q) : WSP(bf16, WS_K)) + (size_t)(r0 + tq8) * D + h * DK + d0);
    const int tv = tid >> 6, e0 = 8 * (tid & 63);
    const u32x4 rawv = *(const u32x4*)(WSP(bf16, WS_V) + (size_t)(r0 + tv) * HV + h * DV + e0);
#pragma unroll
    for (int u = 0; u < 8; ++u) sa[u] = __builtin_nontemporal_load((const f32x4*)(S0 + (size_t)(4 * u) * DV));
    LBAR();
    { float f[8];
#pragma unroll
      for (int i = 0; i < 4; ++i) { f[2 * i] = __uint_as_float(rawqk[i] << 16); f[2 * i + 1] = __uint_as_float(rawqk[i] & 0xffff0000u); }
      if (isq) { *(LAS f32x4*)(qs + tq8 * 260 + d0) = (f32x4){f[0], f[1], f[2], f[3]}; *(LAS f32x4*)(qs + tq8 * 260 + d0 + 4) = (f32x4){f[4], f[5], f[6], f[7]}; }
      else {
#pragma unroll
          for (int i = 0; i < 8; ++i) kt[(d0 + i) * 8 + tq8] = f[i]; } }
    { f32x4 lo, hi;
#pragma unroll
      for (int i = 0; i < 2; ++i) { lo[2 * i] = __uint_as_float(rawv[i] << 16); lo[2 * i + 1] = __uint_as_float(rawv[i] & 0xffff0000u); hi[2 * i] = __uint_as_float(rawv[i + 2] << 16); hi[2 * i + 1] = __uint_as_float(rawv[i + 2] & 0xffff0000u); }
      *(LAS f32x4*)(vs + tv * 512 + e0) = lo; *(LAS f32x4*)(vs + tv * 512 + e0 + 4) = hi; }
    LBAR();
    { const int n = lane >> 3, m = lane & 7; float sx = 0.f;
#pragma unroll 8
      for (int d = 32 * w; d < 32 * w + 32; ++d) sx += qs[n * 260 + d] * kt[d * 8 + m];
      part[w * 64 + lane] = sx; }
    LBAR();
    if (tid < 64) { float sx = 0.f;
#pragma unroll
        for (int i = 0; i < 8; ++i) sx += part[i * 64 + tid];
        pm[tid] = (tid & 7) <= (tid >> 3) ? sx : 0.f; }
    LBAR();
    f32x4 v4[8];
#pragma unroll
    for (int m = 0; m < 8; ++m) v4[m] = *(const LAS f32x4*)(vs + m * 512 + e4);
    f32x4 oacc[4];
#pragma unroll
    for (int i = 0; i < 4; ++i) oacc[i] = (f32x4){0.f, 0.f, 0.f, 0.f};
#define RS_LOAD(dst, it0) do { _Pragma("unroll") for (int u = 0; u < 8; ++u) dst[u] = __builtin_nontemporal_load((const f32x4*)(S0 + (size_t)(4 * ((it0) + u)) * DV)); } while (0)
#define RS_PROC(src, it0) do { _Pragma("unroll") for (int u = 0; u < 8; ++u) { const int d = 4 * ((it0) + u) + fq; \
            const float a = fr < 8 ? qs[fr * 260 + d] : 0.f; \
            _Pragma("unroll") for (int i = 0; i < 4; ++i) oacc[i] = __builtin_amdgcn_mfma_f32_16x16x4f32(a, src[u][i], oacc[i], 0, 0, 0); \
            const f32x4 k0 = *(const LAS f32x4*)(kt + d * 8), k1 = *(const LAS f32x4*)(kt + d * 8 + 4); \
            const f32x4 acc = k0[0] * v4[0] + k0[1] * v4[1] + k0[2] * v4[2] + k0[3] * v4[3] + k1[0] * v4[4] + k1[1] * v4[5] + k1[2] * v4[6] + k1[3] * v4[7]; \
            __builtin_nontemporal_store(g8 * src[u] + g7 * acc, (f32x4*)(S1 + (size_t)(4 * ((it0) + u)) * DV)); } } while (0)
    for (int it0 = 0; it0 < 64; it0 += 16) {
        RS_LOAD(sb, it0 + 8);
        RS_PROC(sa, it0);
        { const int itn = it0 + 16 < 64 ? it0 + 16 : it0; RS_LOAD(sa, itn); }
        RS_PROC(sb, it0 + 8);
    }
#undef RS_LOAD
#undef RS_PROC
    if (fq < 2) {
#pragma unroll
        for (int j = 0; j < 4; ++j) { const int n = 4 * fq + j;
            f32x4 o = (f32x4){oacc[0][j], oacc[1][j], oacc[2][j], oacc[3][j]} * gam;
#pragma unroll
            for (int m = 0; m < 8; ++m) o += pm[n * 8 + m] * v4[m];
            u32x2 o2; o2.x = pk2(o[0], o[1]); o2.y = pk2(o[2], o[3]);
            *(u32x2*)(WSP(bf16, WS_O) + (size_t)(r0 + n) * HV + h * DV + e4) = o2; }
    }
}

__device__ __forceinline__ void p3_retention(Frame& F) {
    const bool stream_first = ((F.vcu >> 3) & 1) != 0;
    const int mode = F.mode;
    if (mode != 1 && stream_first) for (int it = F.vcu; it < 1024; it += F.G) ret_sample_item(F, it);
    if (mode != 2) for (int it = F.vcu; it < 256; it += F.G) ret_prompt_item(F, it);
    if (mode != 1 && !stream_first) for (int it = F.vcu; it < 1024; it += F.G) ret_sample_item(F, it);
}

__device__ __forceinline__ void p4_gn_gate(Frame& F) {
    const int gw = F.vcu * NWAVES + F.wave, NGW = F.G * NWAVES;
    const bf16* O = WSP(bf16, WS_O); const bf16* G = WSP(bf16, WS_G); bf16* A2 = WSP(bf16, WS_A2);
    for (int t = gw; t < M * NH; t += NGW) {
        const int r = t >> 3, h = t & 7; const size_t off = (size_t)r * HV + h * DV + 8 * F.lane;
        const u32x4 ov = *(const u32x4*)(O + off), gv = *(const u32x4*)(G + off);
        float o[8], g[8];
#pragma unroll
        for (int i = 0; i < 4; ++i) { o[2 * i] = __uint_as_float(ov[i] << 16); o[2 * i + 1] = __uint_as_float(ov[i] & 0xffff0000u); g[2 * i] = __uint_as_float(gv[i] << 16); g[2 * i + 1] = __uint_as_float(gv[i] & 0xffff0000u); }
        float s = 0.f;
#pragma unroll
        for (int i = 0; i < 8; ++i) s += o[i];
        const float mu = wave_sum(s) * (1.0f / DV); float q = 0.f;
#pragma unroll
        for (int i = 0; i < 8; ++i) { o[i] -= mu; q += o[i] * o[i]; }
        const float rstd = 1.0f / sqrtf(wave_sum(q) * (1.0f / DV) + 1e-6f);
        const f32x4 w0 = *(const f32x4*)(F.ret_gn_g + h * DV + 8 * F.lane), w1 = *(const f32x4*)(F.ret_gn_g + h * DV + 8 * F.lane + 4);
        float y[8];
#pragma unroll
        for (int i = 0; i < 4; ++i) { y[i] = g[i] * (o[i] * rstd * w0[i]); y[i + 4] = g[i + 4] * (o[i + 4] * rstd * w1[i]); }
        if (FP8O) { u32x2 out; out.x = pk4_fp8(y[0] * S_A2, y[1] * S_A2, y[2] * S_A2, y[3] * S_A2); out.y = pk4_fp8(y[4] * S_A2, y[5] * S_A2, y[6] * S_A2, y[7] * S_A2); *(u32x2*)((unsigned char*)A2 + off) = out; }
        else { u32x4 out; out.x = pk2(y[0], y[1]); out.y = pk2(y[2], y[3]); out.z = pk2(y[4], y[5]); out.w = pk2(y[6], y[7]); *(u32x4*)(A2 + off) = out; }
    }
}
}
namespace mk {
template <int WIN>
__device__ __forceinline__ void pool_walk(const bf16* xrow0  , int nrows, int first_tok  ,
                                          const LAS float* rs, int rs0, const float* hist  , f32x4 gain, f32x4 shift,
                                          bf16* arow0, float* hout  , bool sample, int c4) {
    f32x4 ring[16];
#pragma unroll
    for (int u = 0; u < 16; ++u) ring[u] = (f32x4){0.f, 0.f, 0.f, 0.f};
    for (int i0 = 0; i0 < nrows; i0 += 16) {
        f32x4 xv[16];
#pragma unroll
        for (int u = 0; u < 16; ++u) { int i = i0 + u; i = i < nrows ? i : nrows - 1; int t = first_tok + i; t = t < 0 ? 0 : t;
            xv[u] = (sample && i < 15) ? *(const f32x4*)(hist + (size_t)i * D + c4) : ld_bf4(xrow0 + (ptrdiff_t)(t - first_tok) * D + c4); }
#pragma unroll
        for (int u = 0; u < 16; ++u) {
            const int i = i0 + u;
            if (i < nrows) {
                const int t = first_tok + i;
                f32x4 hv = (f32x4){0.f, 0.f, 0.f, 0.f};
                if (sample && i < 15) hv = xv[u];
                else if (t >= 0) hv = xv[u] * rs[rs0 + i] * gain + shift;
                ring[u] = hv;
                if (i >= 15) {
                    f32x4 s = ring[u];
#pragma unroll
                    for (int j = 1; j < WIN; ++j) s += ring[(u - j) & 15];
                    const int cnt = sample ? WIN : (t + 1 < WIN ? t + 1 : WIN);
                    const f32x4 mm = s * (1.0f / (float)cnt) - hv;
                    u32x2 w; w.x = pk2(mm[0], mm[1]); w.y = pk2(mm[2], mm[3]);
                    *(u32x2*)(arow0 + (ptrdiff_t)i * D + c4) = w;
                }
                if (sample) { if (i >= 8) *(f32x4*)(hout + (size_t)(i - 8) * D + c4) = hv; }
                else if (t >= 2048 - 15) *(f32x4*)(hout + (size_t)(t - (2048 - 15)) * D + c4) = hv;
            }
        }
    }
}
__device__ __forceinline__ void pool_walk_dispatch(int gi, const bf16* xrow0, int nrows, int first_tok, const LAS float* rs, int rs0, const float* hist, f32x4 gain, f32x4 shift, bf16* arow0, float* hout, bool sample, int c4) {
    if (gi == 0) pool_walk<2>(xrow0, nrows, first_tok, rs, rs0, hist, gain, shift, arow0, hout, sample, c4);
    else if (gi == 1) pool_walk<4>(xrow0, nrows, first_tok, rs, rs0, hist, gain, shift, arow0, hout, sample, c4);
    else if (gi == 2) pool_walk<8>(xrow0, nrows, first_tok, rs, rs0, hist, gain, shift, arow0, hout, sample, c4);
    else pool_walk<16>(xrow0, nrows, first_tok, rs, rs0, hist, gain, shift, arow0, hout, sample, c4);
}
__device__ __forceinline__ float row_rstd(Frame& F, int r, bf16* xcur, const bf16* xprev, const bf16* slab, int nparts, const float* gate_l  ) {
    f32x4 v[8];
    if (r < MP) {
#pragma unroll
        for (int j = 0; j < 8; ++j) v[j] = ld_bf4(xcur + (size_t)r * D + 4 * (F.lane + 64 * j)); }
    else { const float* gate = gate_l + (size_t)seq_of(r) * NMOD;
#pragma unroll
        for (int j = 0; j < 8; ++j) { const int c = 4 * (F.lane + 64 * j);
            f32x4 sl[8];
#pragma unroll
            for (int p = 0; p < 8; ++p) sl[p] = ld_bf4(slab + ((size_t)p * MS + (r - MP)) * D + c);
            const f32x4 xp = ld_bf4(xprev + (size_t)r * D + c), gt = *(const f32x4*)(gate + c);
            const f32x4 t = ((sl[0] + sl[1]) + (sl[2] + sl[3])) + ((sl[4] + sl[5]) + (sl[6] + sl[7]));
            v[j] = xp + gt * t;
            { u32x2 w; w.x = pk2(v[j][0], v[j][1]); w.y = pk2(v[j][2], v[j][3]); *(u32x2*)(xcur + (size_t)r * D + c) = w; }
            if ((j & 3) == 3) asm volatile("" ::: "memory"); } }
    float ss = 0.f;
#pragma unroll
    for (int j = 0; j < 8; ++j) ss += (v[j][0] * v[j][0] + v[j][1] * v[j][1]) + (v[j][2] * v[j][2] + v[j][3] * v[j][3]);
    return 1.0f / sqrtf(wave_sum(ss) * (1.0f / D) + 1e-6f);
}
__device__ __forceinline__ void p9_pool_prep(Frame& F, bf16* xcur, const bf16* xprev, const bf16* slab, int nparts, const float* mod_prev  , const float* mod1, const float* rowss) {
    LAS float* rs = (LAS float*)F.lds;
    const int c4 = 4 * F.tid, gi = F.tid >> 7;
    const float* g = F.norm_mix_g + D;
    bf16* A = WSP(bf16, WS_A);
    for (int it = F.vcu; it < 256; it += F.G) {
        __syncthreads();
        const int sb = it < 128 ? it : -1;
        { const int b = it >> 6, ta = 32 * (it & 63), nrows = 47;
            if (F.tid < nrows) { const int t = ta - 15 + F.tid; if (t >= 0) rs[F.tid] = 1.0f / sqrtf(rowss[b * 2048 + t] * (1.0f / D) + 1e-6f); }
            if (sb >= 0) { const float r = row_rstd(F, MP + 8 * sb + F.wave, xcur, xprev, slab, nparts, mod_prev + 5 * D); if (F.lane == 0) rs[64 + F.wave] = r; VM_WAIT(); }
            __syncthreads();
            const float* ms = mod1 + (size_t)b * NMOD;
            const f32x4 gain = *(const f32x4*)(g + c4) * (*(const f32x4*)(ms + 1 * D + c4) + 1.0f), shift = *(const f32x4*)(ms + c4);
            pool_walk_dispatch(gi, xcur + (ptrdiff_t)(b * 2048 + ta - 15) * D, nrows, ta - 15, rs, 0, nullptr, gain, shift, A + (ptrdiff_t)(b * 2048 + ta - 15) * D, F.sp_p + (size_t)b * 15 * D, false, c4); }
        if (sb >= 0) { const int b = sb; const float* ms = mod1 + (size_t)(4 + b) * NMOD;
            const f32x4 gain = *(const f32x4*)(g + c4) * (*(const f32x4*)(ms + 1 * D + c4) + 1.0f), shift = *(const f32x4*)(ms + c4);
            pool_walk_dispatch(gi, xcur + (ptrdiff_t)(MP + 8 * b - 15) * D, 23, -15, rs, 64 - 15, F.state_pool + (size_t)b * 15 * D, gain, shift, A + (ptrdiff_t)(MP + 8 * b - 15) * D, F.sp_s + (size_t)b * 15 * D, true, c4); }
    }
}

__global__ void __launch_bounds__(NTHREADS, 2) mk_fwd(Args args) {
    extern __shared__ __attribute__((aligned(16))) unsigned char lds_raw[];
    Frame F;
    F.lds = (LAS unsigned char*)lds_raw;
    F.tid = threadIdx.x; F.lane = F.tid & 63; F.wave = __builtin_amdgcn_readfirstlane(F.tid >> 6);
    F.G = gridDim.x; { const int bx = blockIdx.x; F.vcu = (F.G % 8 == 0) ? (bx % 8) * (F.G / 8) + bx / 8 : bx; }
    F.x_p = args.in[0]; F.x_s = args.in[1]; F.c_p = args.in[2]; F.c_s = args.in[3]; F.state_ret = args.in[4]; F.state_pool = args.in[5]; F.norm_mix_g = args.in[6]; F.norm_ffn_g = args.in[7];
    F.ada_w = args.in[8]; F.ada_b = args.in[9]; F.ret_w_in = args.in[10]; F.ret_gn_g = args.in[11]; F.ret_w_out = args.in[12]; F.pool_w = args.in[13]; F.pool_scale = args.in[14];
    F.ffn_w_in = args.in[15]; F.ffn_w_out = args.in[16]; F.final_g = args.in[17];
    F.y = args.out; F.sr_p = F.y + (size_t)M * D; F.sp_p = F.sr_p + (size_t)4 * NH * DK * DV; F.sr_s = F.sp_p + (size_t)4 * 15 * D; F.sp_s = F.sr_s + (size_t)128 * NH * DK * DV;
    F.ws = args.ws; F.mode = MK_EXPERIMENT ? args.mode : 0;
    volatile LAS unsigned* MISC = (volatile LAS unsigned*)(F.lds + MISC_OFF);
    if (F.tid < 32) MISC[F.tid] = 0u;
    __syncthreads();
    unsigned* ctl = (unsigned*)(F.ws + WS_CTL);
    const int lo = args.ph_lo, hi = args.ph_hi;
    const bool use_bar = (hi - lo) > 1;
    XcdBarrier bar; bar.bar = ctl + CW_BAR; bar.x = 0; bar.st = nullptr;
    if (use_bar) bar = xcd_barrier_post(ctl + CW_BAR, MISC + 8);
#ifndef MK_PHASE_MASK
#define MK_PHASE_MASK 0x7fff
#endif
#define IN(k) ((((MK_PHASE_MASK) >> (k)) & 1) && lo <= (k) && (k) < hi)
#if defined(MK_STAMPS)
    unsigned long long* stp = (unsigned long long*)(F.ws + ((size_t)900 << 20)) + (size_t)blockIdx.x * 64;
    if (F.tid == 0) { stp[60] = __builtin_amdgcn_s_memrealtime(); stp[62] = (unsigned long long)clock64(); }
    unsigned long long* stq = (unsigned long long*)(F.ws + ((size_t)901 << 20)) + (size_t)blockIdx.x * 64;
#define GST(k) , stq + 4 * (k)
#define SEAM(k) do { if (IN(k) && IN((k) + 1)) { if (F.tid == 0) { stp[2 * (k)] = __builtin_amdgcn_s_memrealtime(); stp[32 + 2 * (k)] = (unsigned long long)clock64(); } xcd_barrier(bar); if (F.tid == 0) { stp[2 * (k) + 1] = __builtin_amdgcn_s_memrealtime(); stp[32 + 2 * (k) + 1] = (unsigned long long)clock64(); } } } while (0)
#else
#define GST(k)
#define SEAM(k) do { if (IN(k) && IN((k) + 1)) xcd_barrier(bar); } while (0)
#endif
    float* mod0 = WSP(float, WS_MOD); float* mod1 = mod0 + (size_t)NSEQ * NMOD;
    bf16* X1 = WSP(bf16, WS_X1); bf16* X2 = WSP(bf16, WS_X2); bf16* SLAB = WSP(bf16, WS_SLAB);
    bf16* A = WSP(bf16, WS_A);
    const float* xs_shift = F.x_s - (size_t)MP * D;
    const int ord_c = (int)blockIdx.x;

    if (IN(0)) { p0_prologue(F); } SEAM(0);
    if (IN(1)) { norm_rows<0, 0, 0, false>(F, nullptr, nullptr, nullptr, nullptr, mod0, 0, nullptr, F.norm_mix_g, 0, 1, A, nullptr);
        transpose_range(F, TR_P0_END + F.vcu * NWAVES + F.wave, TR_P1_END, F.G * NWAVES, (LAS float*)(F.lds + F.wave * 16384)); } SEAM(1);
    if (IN(2)) {
        pg8::Gemm g{A, WSP(bf16, WS_WIN), D * 2, D * 2}; pg8::OrdStatic S; S.init(M, NPROJ, D * 2, F.G, ord_c);
        pg8::EpiProj E{WSP(bf16, WS_Q), WSP(bf16, WS_K), WSP(bf16, WS_V), WSP(bf16, WS_G), WSP(float2, WS_ROPE)};
        pg8::gemm_phase<false>(F.lds, g, S, E GST(2));
        { const int nfull = S.nwg % F.G;
          if (nfull > 0) transpose_tail(F, TR_P1_END, TR_P2_END, ord_c >= nfull ? ord_c - nfull : -1, F.G - nfull);
          else transpose_tail(F, TR_P1_END, TR_P2_END, ord_c, F.G); }
    } SEAM(2);
    if (IN(3)) { p3_retention(F); } SEAM(3);
    if (IN(4)) { p4_gn_gate(F); } SEAM(4);
    if (IN(5)) {
        pg8::Gemm g{WSP(bf16, WS_A2), WSP(bf16, WS_WOUT), HV * OES, HV * OES}; pg8::OrdSplit S; S.init(HV * OES, 8, 0, F.G, ord_c);
        pg8::EpiResid<0, true> E{F.x_p, X1, mod0 + 2 * D, SLAB, nullptr, FP8O ? 1.0f / (S_A2 * S_WO) : 1.0f};
        pg8::gemm_phase<FP8O>(F.lds, g, S, E GST(5));
    } SEAM(5);
    if (IN(6)) { norm_rows<1, FP8 ? 2 : 0, 8, true>(F, X1, X1, xs_shift, SLAB, mod0, 2, nullptr, F.norm_ffn_g, 3, 4, A, nullptr); } SEAM(6);
    if (IN(7)) {
        pg8::Gemm g{A, F.ws + WS_WF1, D * FES, D * FES}; pg8::OrdStatic S; S.init(M, 2 * FF, D * FES, F.G, ord_c);
        pg8::EpiSwiglu<FP8> E{F.ws + WS_HID
#if MK_EXPERIMENT
            , F.mode
#endif
            };
        pg8::gemm_phase<FP8>(F.lds, g, S, E GST(7));
        { const int nfull = S.nwg % F.G;
          if (nfull > 0) transpose_tail(F, TR_P2_END, TR_P7_END, ord_c >= nfull ? ord_c - nfull : -1, F.G - nfull);
          else transpose_tail(F, TR_P2_END, TR_P7_END, ord_c, F.G); }
    } SEAM(7);
    if (IN(8)) {
        pg8::Gemm g{F.ws + WS_HID, F.ws + WS_WF2, FF * FES, FF * FES}; pg8::OrdSplit S; S.init(FF * FES, 8, 0, F.G, ord_c);
        pg8::EpiResid<2, false> E{X1, X2, mod0 + 5 * D, SLAB, (float*)(ctl + CW_ROWSS), FP8 ? 1.0f / (S_HID * S_W2) : 1.0f};
        pg8::gemm_phase<FP8>(F.lds, g, S, E GST(8));
    } SEAM(8);
    if (IN(9)) { p9_pool_prep(F, X2, X1, SLAB, 8, mod0, mod1, (const float*)(ctl + CW_ROWSS)); } SEAM(9);
    if (IN(10)) {
        pg8::Gemm g{A, WSP(bf16, WS_WPOOL), D * 2, 512 * 2}; pg8::OrdSplit S; S.init(512 * 2, 2, 1, F.G, ord_c);
        pg8::EpiResid<1, false> E{X2, X1, mod1 + 2 * D, SLAB, const_cast<float*>(F.pool_scale), 1.0f};
        pg8::gemm_phase<false>(F.lds, g, S, E GST(10));
    } SEAM(10);
    if (IN(11)) { norm_rows<1, FP8 ? 2 : 0, 2, false>(F, X1, X1, X2, SLAB, mod1, 2, F.pool_scale, F.norm_ffn_g + D, 3, 4, A, nullptr); } SEAM(11);
    if (IN(12)) {
        pg8::Gemm g{A, F.ws + WS_WF1 + (size_t)2 * FF * D * FES, D * FES, D * FES}; pg8::OrdStaticH S; S.init(M, 2 * FF, D * FES, F.G, ord_c);
        pg8::EpiSwiglu<FP8> E{F.ws + WS_HID
#if MK_EXPERIMENT
            , F.mode
#endif
            };
        pg8::gemm_phase<FP8>(F.lds, g, S, E GST(12));
        { const int nfull = S.tail_first();
          if (nfull > 0) transpose_tail(F, TR_P7_END, TI_TOTAL, ord_c >= nfull ? ord_c - nfull : -1, F.G - nfull);
          else transpose_tail(F, TR_P7_END, TI_TOTAL, ord_c, F.G); }
    } SEAM(12);
    if (IN(13)) {
        pg8::Gemm g{F.ws + WS_HID, F.ws + WS_WF2 + (size_t)D * FF * FES, FF * FES, FF * FES}; pg8::OrdSplit S; S.init(FF * FES, 8, 0, F.G, ord_c);
        pg8::EpiResid<0, false> E{X1, X2, mod1 + 5 * D, SLAB, nullptr, FP8 ? 1.0f / (S_HID * S_W2) : 1.0f};
        pg8::gemm_phase<FP8>(F.lds, g, S, E GST(13));
    } SEAM(13);
    if (IN(14)) { norm_rows<1, 1, 8, false>(F, X2, X2, X1, SLAB, mod1, 5, nullptr, F.final_g, 0, 0, nullptr, F.y); }
#if defined(MK_STAMPS)
    VM_WAIT(); if (F.tid == 0) { stp[61] = __builtin_amdgcn_s_memrealtime(); stp[63] = (unsigned long long)clock64(); }
#endif
#undef IN
#undef SEAM
#undef GST
}

static int g_grid = 0;
static bool mk_setup() {
    if (g_grid) return g_grid > 0;
    int dev = 0, cus = 0, per_cu = 0;
    if (hipGetDevice(&dev) != hipSuccess || hipDeviceGetAttribute(&cus, hipDeviceAttributeMultiprocessorCount, dev) != hipSuccess) { g_grid = -1; return false; }
    if (hipFuncSetAttribute((const void*)mk_fwd, hipFuncAttributeMaxDynamicSharedMemorySize, LDS_BYTES) != hipSuccess) { fprintf(stderr, "mk: hipFuncSetAttribute failed\n"); g_grid = -1; return false; }
    if (hipOccupancyMaxActiveBlocksPerMultiprocessor(&per_cu, (const void*)mk_fwd, NTHREADS, LDS_BYTES) != hipSuccess || per_cu < 1) fprintf(stderr, "mk: occupancy query says %d\n", per_cu);
    (void)hipGetLastError();
    g_grid = cus;
    return true;
}
static void mk_launch(void* const* d_in, float* out, unsigned char* ws, int lo, int hi, hipStream_t st, int mode = 0) {
    Args a{};
    for (int i = 0; i < 18; ++i) a.in[i] = (const float*)d_in[i];
    a.out = out; a.ws = ws; a.ph_lo = lo; a.ph_hi = hi; a.mode = mode; a.pad = 0;
    hipLaunchKernelGGL(mk_fwd, dim3(g_grid), dim3(NTHREADS), LDS_BYTES, st, a);
}
}
extern "C" void kernel_launch(void* const* d_in, const int* in_sizes, int n_in, void* d_out, int out_size, void* d_ws, size_t ws_size, hipStream_t stream) {
    if (!mk::mk_setup()) return;
    hipMemsetAsync(d_ws, 0, mk::CTL_ZERO_BYTES, stream);
    mk::mk_launch(d_in, (float*)d_out, (unsigned char*)d_ws, 0, 15, stream);
}
```

```cpp
#include <hip/hip_runtime.h>
#include <math.h>
#include <stdio.h>
#include <stdint.h>
namespace mk {
#define LAS __attribute__((address_space(3)))
#define GAS __attribute__((address_space(1)))
typedef unsigned short bf16;
typedef short bf16x8 __attribute__((ext_vector_type(8)));
typedef short s16x4 __attribute__((ext_vector_type(4)));
typedef float f32x4 __attribute__((ext_vector_type(4)));
typedef float f32x2 __attribute__((ext_vector_type(2)));
typedef unsigned u32x4 __attribute__((ext_vector_type(4)));
typedef unsigned u32x2 __attribute__((ext_vector_type(2)));
typedef short v4i16_t __attribute__((ext_vector_type(4)));

constexpr int D = 2048, MP = 8192, MS = 1024, M = 9216, NSEQ = 132, NMOD = 12288, NH = 8, DK = 256, DV = 512, FF = 5632, NPROJ = 12288, HV = 4096;
constexpr int NWAVES = 8, NTHREADS = 512;
constexpr size_t MiB = 1u << 20;
constexpr size_t WS_CTL = 0, CTL_ZERO_BYTES = 1 * MiB;
constexpr size_t WS_ROPE = 1 * MiB;
constexpr size_t WS_MOD = 4 * MiB;
constexpr size_t WS_SILU = 17 * MiB;
constexpr size_t WS_WIN = 18 * MiB;
constexpr size_t WS_WOUT = 66 * MiB;
constexpr size_t WS_WF1 = 82 * MiB;
constexpr size_t WS_WF2 = 170 * MiB;
constexpr size_t WS_WPOOL = 214 * MiB;
constexpr size_t WS_A = 216 * MiB;
constexpr size_t WS_Q = 252 * MiB, WS_K = 288 * MiB;
constexpr size_t WS_V = 324 * MiB, WS_G = 396 * MiB;
constexpr size_t WS_O = 468 * MiB;
constexpr size_t WS_A2 = 540 * MiB;
constexpr size_t WS_X1 = 612 * MiB, WS_X2 = 684 * MiB;
constexpr size_t WS_SLAB = 756 * MiB;
constexpr size_t WS_HID = 252 * MiB;
constexpr size_t WS_END = 820 * MiB;
static_assert(WS_HID + (size_t)M * FF * 2 <= WS_G + (size_t)M * HV * 2, "hid overlay");
constexpr int CW_TMO = 0, CW_BAR = 4096, CW_SILU = 8192, CW_ROWSS = 32768;
#ifndef MK_FP8
#define MK_FP8 1
#endif
constexpr bool FP8 = MK_FP8 != 0;
constexpr int FES = FP8 ? 1 : 2;
constexpr float S_H2 = 16.0f, S_W1 = 512.0f, S_HID = 8.0f, S_W2 = 1024.0f, S_A2 = 8.0f, S_WO = 1024.0f;
#ifndef MK_FP8_WOUT
#define MK_FP8_WOUT 1
#endif
constexpr bool FP8O = FP8 && (MK_FP8_WOUT != 0);
constexpr int OES = FP8O ? 1 : 2;

constexpr int LDS_BYTES = 147456, MISC_OFF = 131072 + 320;

#ifndef MK_EXPERIMENT
#define MK_EXPERIMENT 0
#endif
struct Args { const float* in[18]; float* out; unsigned char* ws; int ph_lo, ph_hi, mode, pad; };

__device__ __forceinline__ unsigned pk2(float lo, float hi) { unsigned r; asm("v_cvt_pk_bf16_f32 %0, %1, %2" : "=v"(r) : "v"(lo), "v"(hi)); return r; }
__device__ __forceinline__ unsigned pk4_fp8(float a, float b, float c, float d) {
    a = __builtin_fminf(__builtin_fmaxf(a, -440.f), 440.f); b = __builtin_fminf(__builtin_fmaxf(b, -440.f), 440.f); c = __builtin_fminf(__builtin_fmaxf(c, -440.f), 440.f); d = __builtin_fminf(__builtin_fmaxf(d, -440.f), 440.f);
    int w = 0; w = __builtin_amdgcn_cvt_pk_fp8_f32(a, b, w, false); w = __builtin_amdgcn_cvt_pk_fp8_f32(c, d, w, true); return (unsigned)w; }
__device__ __forceinline__ f32x4 ld_bf4(const bf16* p) { const u32x2 w = *(const u32x2*)p; return (f32x4){__uint_as_float(w.x << 16), __uint_as_float(w.x & 0xffff0000u), __uint_as_float(w.y << 16), __uint_as_float(w.y & 0xffff0000u)}; }
__device__ __forceinline__ float bf2f(unsigned short b) { return __uint_as_float(((unsigned)b) << 16); }
__device__ __forceinline__ float silu_f(float v) { return v * __builtin_amdgcn_rcpf(1.0f + __builtin_amdgcn_exp2f(-1.44269504089f * v)); }
__device__ __forceinline__ int seq_of(int r) { return r < MP ? (r >> 11) : 4 + ((r - MP) >> 3); }
__device__ __forceinline__ float wave_sum(float v) {
#pragma unroll
    for (int o = 1; o < 64; o <<= 1) v += __shfl_xor(v, o);
    return v;
}
#define LDS_WAIT() asm volatile("s_waitcnt lgkmcnt(0)" ::: "memory")
#define VM_WAIT() asm volatile("s_waitcnt vmcnt(0)" ::: "memory")

#define XB_TMO      128
#define XB_XCNT(j)  (256  + 64 * (j))
#define XB_XSUB(j)  (1280 + 64 * (j))
#define XB_XGEN(j)  (2304 + 64 * (j))
#define XB_TOP      3328
#define XB_TOPGEN   3392
#define XCD_BAR_WORDS 3456
#define XB_SPIN_CAP (1u << 18)
__device__ __forceinline__ unsigned xb_ld(unsigned* p)              { return __hip_atomic_load(p, __ATOMIC_RELAXED, __HIP_MEMORY_SCOPE_AGENT); }
__device__ __forceinline__ unsigned xb_add(unsigned* p, unsigned v) { return __hip_atomic_fetch_add(p, v, __ATOMIC_RELAXED, __HIP_MEMORY_SCOPE_AGENT); }
__device__ __forceinline__ unsigned xb_xcc_id() { return (unsigned)__builtin_amdgcn_s_getreg((3 << 11) | 20) & 0xFu; }
#define XB_SPIN(cond, bar) do { unsigned _sp = 0; while (cond) { __builtin_amdgcn_s_sleep(1); \
    if ((++_sp & 255u) == 0u) { if (xb_ld(&(bar)[XB_TMO])) break; if (_sp > XB_SPIN_CAP) { atomicAdd(&(bar)[XB_TMO], 1u); break; } } } } while (0)
struct XcdBarrier { unsigned* bar; unsigned x; volatile LAS unsigned* st; };
__device__ __forceinline__ XcdBarrier xcd_barrier_post(unsigned* bar, volatile LAS unsigned* st) {
    XcdBarrier b; b.bar = bar; b.x = xb_xcc_id(); b.st = st;
    if (threadIdx.x == 0) (void)xb_add(&bar[XB_XCNT(b.x)], 1u);
    return b;
}
__device__ __forceinline__ void xcd_barrier_complete(unsigned* bar, unsigned x, unsigned& nloc, unsigned& nx) {
    const unsigned G = gridDim.x * gridDim.y * gridDim.z;
    unsigned sum, cnt, mine, sp = 0u;
    for (;;) {
        sum = 0u; cnt = 0u; mine = 0u;
#pragma unroll
        for (unsigned j = 0; j < 16; ++j) { const unsigned c = xb_ld(&bar[XB_XCNT(j)]); sum += c; cnt += (c > 0u) ? 1u : 0u; mine = (j == x) ? c : mine; }
        if (sum == G) break;
        __builtin_amdgcn_s_sleep(1);
        if ((++sp & 255u) == 0u) { if (xb_ld(&bar[XB_TMO])) break; if (sp > XB_SPIN_CAP) { atomicAdd(&bar[XB_TMO], 1u); break; } }
    }
    nloc = mine > 0u ? mine : 1u; nx = cnt > 0u ? cnt : 1u;
}
__device__ __forceinline__ void xcd_barrier(const XcdBarrier& b) {
    asm volatile("s_waitcnt vmcnt(0)" ::: "memory");
    __syncthreads();
    if (threadIdx.x == 0) {
        unsigned* bar = b.bar;
        __builtin_amdgcn_s_waitcnt(0);
        unsigned nloc = b.st[0], nx = b.st[1];
        if (nloc == 0u) { xcd_barrier_complete(bar, b.x, nloc, nx); b.st[0] = nloc; b.st[1] = nx; }
        const unsigned old = xb_add(&bar[XB_XSUB(b.x)], 1u);
        const unsigned gen = old / nloc;
        if (old + 1u == (gen + 1u) * nloc) {
            __builtin_amdgcn_fence(__ATOMIC_RELEASE, "agent");
            asm volatile("s_waitcnt vmcnt(0)" ::: "memory");
            const unsigned og = xb_add(&bar[XB_TOP], 1u);
            const unsigned tg = og / nx;
            if (og + 1u == (tg + 1u) * nx) xb_add(&bar[XB_TOPGEN], 1u);
            else XB_SPIN(xb_ld(&bar[XB_TOPGEN]) == tg, bar);
            __builtin_amdgcn_fence(__ATOMIC_ACQUIRE, "agent");
            xb_add(&bar[XB_XGEN(b.x)], 1u);
            asm volatile("s_waitcnt vmcnt(0)" ::: "memory");
        } else {
            XB_SPIN(xb_ld(&bar[XB_XGEN(b.x)]) == gen, bar);
            __builtin_amdgcn_fence(__ATOMIC_ACQUIRE, "agent");
            asm volatile("s_waitcnt vmcnt(0)" ::: "memory");
        }
    }
    __syncthreads();
}

struct Frame {
    LAS unsigned char* lds;
    int tid, lane, wave, vcu, G, mode;
    const float *x_p, *x_s, *c_p, *c_s, *state_ret, *state_pool, *norm_mix_g, *norm_ffn_g, *ada_w, *ada_b, *ret_w_in, *ret_gn_g, *ret_w_out, *pool_w, *pool_scale, *ffn_w_in, *ffn_w_out, *final_g;
    float *y, *sr_p, *sp_p, *sr_s, *sp_s;
    unsigned char* ws;
};
#define WSP(T, off) ((T*)(F.ws + (off)))

struct TItem { const float* src; unsigned char* dst; int ldw, ldt, fp8; float scale; };
constexpr int TI_WIN = 32 * 384, TI_WOUT = 64 * 64, TI_F1 = 32 * 352, TI_F2 = 88 * 64, TI_POOL = 4 * 8 * 16;
constexpr int TI_TOTAL = TI_WIN + TI_WOUT + 2 * TI_F1 + 2 * TI_F2 + TI_POOL;
static_assert(TI_TOTAL == 50688 && 128 * 128 == TI_WIN + TI_WOUT, "transpose item count");
constexpr int TR_P0_END = TI_WIN + TI_WOUT, TR_P1_END = TR_P0_END + 7168  , TR_P2_END = TR_P0_END + TI_F1, TR_P7_END = TR_P2_END + TI_F2 + TI_POOL + TI_F1;
__device__ __forceinline__ TItem titem_decode(Frame& F, int it) {
    int r = it; TItem t; t.fp8 = 0; t.scale = 1.0f;
    if (r < TI_WIN) { const int kb = r / 384, nb = r % 384; t.ldw = NPROJ; t.ldt = D * 2; t.src = F.ret_w_in + (size_t)(64 * kb) * NPROJ + 32 * nb; t.dst = F.ws + WS_WIN + ((size_t)(32 * nb) * D + 64 * kb) * 2; return t; } r -= TI_WIN;
    if (r < TI_WOUT) { const int kb = r / 64, nb = r % 64; t.fp8 = FP8O; t.scale = FP8O ? S_WO : 1.0f; t.ldw = D; t.ldt = HV * OES; t.src = F.ret_w_out + (size_t)(64 * kb) * D + 32 * nb; t.dst = F.ws + WS_WOUT + ((size_t)(32 * nb) * HV + 64 * kb) * OES; return t; } r -= TI_WOUT;
    int l = 0;
    if (r >= TI_F1 + TI_F2 + TI_POOL) { l = 1; r -= TI_F1 + TI_F2 + TI_POOL; }
    if (r < TI_F1) { const int kb = r / 352, nb = r % 352, n0 = 32 * nb;
        const int j = n0 < FF ? n0 : n0 - FF; const int row = 256 * (j >> 7) + (j & 127) + (n0 < FF ? 0 : 128);
        t.fp8 = FP8; t.scale = FP8 ? S_W1 : 1.0f;
        t.ldw = 2 * FF; t.ldt = D * FES; t.src = F.ffn_w_in + (size_t)l * D * 2 * FF + (size_t)(64 * kb) * (2 * FF) + n0; t.dst = F.ws + WS_WF1 + ((size_t)l * 2 * FF * D + (size_t)row * D + 64 * kb) * FES; return t; } r -= TI_F1;
    if (r < TI_F2) { const int kb = r / 64, nb = r % 64;
        t.fp8 = FP8; t.scale = FP8 ? S_W2 : 1.0f;
        t.ldw = D; t.ldt = FF * FES; t.src = F.ffn_w_out + (size_t)l * FF * D + (size_t)(64 * kb) * D + 32 * nb; t.dst = F.ws + WS_WF2 + ((size_t)l * D * FF + (size_t)(32 * nb) * FF + 64 * kb) * FES; return t; } r -= TI_F2;
    { const int g = r / 128; r -= g * 128; const int kb = r / 16, nb = r % 16;
        t.ldw = 512; t.ldt = 512 * 2; t.src = F.pool_w + (size_t)g * 512 * 512 + (size_t)(64 * kb) * 512 + 32 * nb; t.dst = F.ws + WS_WPOOL + ((size_t)(512 * g + 32 * nb) * 512 + 64 * kb) * 2; return t; }
}
__device__ __forceinline__ void titem_load(const TItem& t, float (&v)[32], int lane) {
    const float* p = t.src + (size_t)(lane >> 5) * t.ldw + (lane & 31);
#pragma unroll
    for (int i = 0; i < 32; ++i) v[i] = p[(size_t)(2 * i) * t.ldw];
}
__device__ __forceinline__ void titem_finish(const TItem& t, const float (&v)[32], LAS float* scr, int lane) {
#pragma unroll
    for (int i = 0; i < 32; ++i) scr[(2 * i + (lane >> 5)) * 33 + (lane & 31)] = v[i];
    LDS_WAIT(); asm volatile("" ::: "memory");
    const int c = lane & 7;
    if (t.fp8) {
#pragma unroll
        for (int j = 0; j < 4; ++j) { const int n = (lane >> 3) + 8 * j; const LAS float* s = scr + (8 * c) * 33 + n; const float sc = t.scale;
            u32x2 o; o.x = pk4_fp8(s[0 * 33] * sc, s[1 * 33] * sc, s[2 * 33] * sc, s[3 * 33] * sc); o.y = pk4_fp8(s[4 * 33] * sc, s[5 * 33] * sc, s[6 * 33] * sc, s[7 * 33] * sc);
            *(GAS u32x2*)(t.dst + (size_t)n * t.ldt + 8 * c) = o; }
    } else {
#pragma unroll
        for (int j = 0; j < 4; ++j) { const int n = (lane >> 3) + 8 * j; const LAS float* s = scr + (8 * c) * 33 + n;
            u32x4 o; o.x = pk2(s[0 * 33], s[1 * 33]); o.y = pk2(s[2 * 33], s[3 * 33]); o.z = pk2(s[4 * 33], s[5 * 33]); o.w = pk2(s[6 * 33], s[7 * 33]);
            *(GAS u32x4*)(t.dst + (size_t)n * t.ldt + 16 * c) = o; }
    }
    LDS_WAIT(); asm volatile("" ::: "memory");
}
__device__ __forceinline__ void transpose_range(Frame& F, int first, int end, int step, LAS float* scr) {
    if (first >= end) return;
    float cur[32], n1[32], n2[32];
    TItem tc = titem_decode(F, first); titem_load(tc, cur, F.lane);
    TItem t1 = titem_decode(F, first + step < end ? first + step : first); titem_load(t1, n1, F.lane);
    for (int it = first; it < end; it += step) {
        const int it2 = it + 2 * step < end ? it + 2 * step : it;
        const TItem t2 = titem_decode(F, it2); titem_load(t2, n2, F.lane);
        titem_finish(tc, cur, scr, F.lane);
        tc = t1; t1 = t2;
#pragma unroll
        for (int i = 0; i < 32; ++i) { cur[i] = n1[i]; n1[i] = n2[i]; }
    }
}
__device__ __forceinline__ void transpose_tail(Frame& F, int first, int end, int rank, int nidle) {
    if (rank < 0) return;
    transpose_range(F, first + rank * NWAVES + F.wave, end, nidle * NWAVES, (LAS float*)(F.lds + F.wave * 16384));
}
__device__ __forceinline__ void ada_item(Frame& F, int item) {
    const int l = item / 192, n0 = F.mode == 3 ? 0 : (item % 192) * 64;
    const float* W = F.ada_w + (size_t)l * D * NMOD;
    const int kq = F.wave & 3, mh = F.wave >> 2, fr = F.lane & 15, fq = F.lane >> 4;
    f32x4 acc[5][4];
#pragma unroll
    for (int a = 0; a < 5; ++a)
#pragma unroll
        for (int b = 0; b < 4; ++b) acc[a][b] = (f32x4){0.f, 0.f, 0.f, 0.f};
    const float* wp = W + (size_t)(512 * kq + 8 * fq) * NMOD + n0 + 4 * fr;
    const bf16* ap[5];
#pragma unroll
    for (int mt = 0; mt < 5; ++mt) { const int s = 16 * (5 * mh + mt) + fr;
        ap[mt] = WSP(bf16, WS_SILU) + (size_t)(s < 144 ? s : 143) * D + 512 * kq + 8 * fq; }
    f32x4 w4[8]; bf16x8 a4[5];
#pragma unroll
    for (int kk = 0; kk < 8; ++kk) w4[kk] = *(const f32x4*)(wp + (size_t)kk * NMOD);
#pragma unroll
    for (int mt = 0; mt < 5; ++mt) a4[mt] = *(const bf16x8*)(ap[mt]);
#pragma unroll 1
    for (int ks = 0; ks < 16; ++ks) {
        const int ksn = ks + 1 < 16 ? ks + 1 : ks;
        f32x4 wn[8]; bf16x8 an[5];
#pragma unroll
        for (int kk = 0; kk < 8; ++kk) wn[kk] = *(const f32x4*)(wp + (size_t)(ksn * 32 + kk) * NMOD);
#pragma unroll
        for (int mt = 0; mt < 5; ++mt) an[mt] = *(const bf16x8*)(ap[mt] + 32 * ksn);
        bf16x8 bfr[4];
#pragma unroll
        for (int i = 0; i < 4; ++i) { u32x4 p; p.x = pk2(w4[0][i], w4[1][i]); p.y = pk2(w4[2][i], w4[3][i]); p.z = pk2(w4[4][i], w4[5][i]); p.w = pk2(w4[6][i], w4[7][i]); bfr[i] = __builtin_bit_cast(bf16x8, p); }
#pragma unroll
        for (int mt = 0; mt < 5; ++mt)
#pragma unroll
            for (int i = 0; i < 4; ++i) acc[mt][i] = __builtin_amdgcn_mfma_f32_16x16x32_bf16(a4[mt], bfr[i], acc[mt][i], 0, 0, 0);
#pragma unroll
        for (int kk = 0; kk < 8; ++kk) w4[kk] = wn[kk];
#pragma unroll
        for (int mt = 0; mt < 5; ++mt) a4[mt] = an[mt];
    }
    LAS float* red = (LAS float*)F.lds;
    if (kq > 0) {
        LAS float* rp = red + (size_t)((mh * 3 + kq - 1) * 80) * 64 + F.lane;
#pragma unroll
        for (int mt = 0; mt < 5; ++mt)
#pragma unroll
            for (int i = 0; i < 4; ++i)
#pragma unroll
                for (int j = 0; j < 4; ++j) rp[((mt * 4 + i) * 4 + j) * 64] = acc[mt][i][j];
    }
    __syncthreads();
    if (kq == 0) {
#pragma unroll 1
        for (int r = 0; r < 3; ++r) { const LAS float* rp = red + (size_t)((mh * 3 + r) * 80) * 64 + F.lane;
#pragma unroll
            for (int mt = 0; mt < 5; ++mt) {
#pragma unroll
                for (int i = 0; i < 4; ++i)
#pragma unroll
                    for (int j = 0; j < 4; ++j) acc[mt][i][j] += rp[((mt * 4 + i) * 4 + j) * 64];
                asm volatile("" ::: "memory"); } }
        const f32x4 b4 = *(const f32x4*)(F.ada_b + (size_t)l * NMOD + n0 + 4 * fr);
        float* mod = WSP(float, WS_MOD) + (size_t)l * NSEQ * NMOD + n0 + 4 * fr;
#pragma unroll
        for (int mt = 0; mt < 5; ++mt)
#pragma unroll
            for (int j = 0; j < 4; ++j) { const int s = 16 * (5 * mh + mt) + 4 * fq + j;
                if (s < NSEQ) *(f32x4*)(mod + (size_t)s * NMOD) = (f32x4){acc[mt][0][j], acc[mt][1][j], acc[mt][2][j], acc[mt][3][j]} + b4; }
    }
    __syncthreads();
}
static __device__ const float ROPE_INV_FREQ[128] = {
    1.0f, 0.930572033f, 0.865964353f, 0.805842221f, 0.749894202f, 0.697830558f, 0.649381638f, 0.604296386f, 0.562341332f, 0.523299158f, 0.486967534f, 0.453158349f, 0.421696514f, 0.392418981f, 0.365174145f, 0.339820832f, 0.316227764f, 0.294272721f, 0.273841977f, 0.254829675f, 0.237137362f, 0.220673397f, 0.2053525f, 0.191095293f, 0.177827939f, 0.165481701f, 0.153992653f, 0.143301263f, 0.133352146f, 0.124093771f, 0.115478203f, 0.107460782f, 0.100000001f, 0.0930572003f, 0.0865964293f, 0.0805842131f, 0.0749894157f, 0.0697830543f, 0.0649381652f, 0.0604296438f, 0.0562341288f, 0.0523299128f, 0.0486967526f, 0.0453158356f, 0.0421696492f, 0.0392418988f, 0.0365174115f, 0.0339820832f, 0.0316227786f, 0.0294272732f, 0.0273841955f, 0.0254829675f, 0.0237137359f, 0.0220673401f, 0.0205352511f, 0.0191095304f, 0.0177827943f, 0.0165481716f, 0.0153992651f, 0.0143301254f, 0.0133352149f, 0.0124093769f, 0.0115478197f, 0.0107460786f, 0.00999999978f, 0.00930572022f, 0.00865964312f, 0.00805842225f, 0.00749894232f, 0.00697830599f, 0.00649381662f, 0.00604296429f, 0.00562341325f, 0.00523299119f, 0.00486967526f, 0.00453158375f, 0.00421696482f, 0.0039241896f, 0.00365174143f, 0.00339820841f, 0.00316227786f, 0.00294272718f, 0.00273841969f, 0.0025482967f, 0.00237137382f, 0.00220673415f, 0.00205352507f, 0.00191095285f, 0.00177827943f, 0.00165481714f, 0.00153992651f, 0.00143301266f, 0.00133352145f, 0.00124093785f, 0.00115478202f, 0.00107460783f, 0.00100000005f, 0.000930572103f, 0.000865964335f, 0.000805842225f, 0.000749894185f, 0.000697830576f, 0.000649381662f, 0.000604296394f, 0.000562341302f, 0.000523299095f, 0.000486967503f, 0.00045315834f, 0.000421696488f, 0.000392418995f, 0.000365174114f, 0.000339820806f, 0.000316227786f, 0.00029427273f, 0.000273841957f, 0.000254829676f, 0.000237137385f, 0.000220673421f, 0.000205352495f, 0.0001910953f, 0.00017782794f, 0.000165481717f, 0.000153992645f, 0.000143301266f, 0.00013335215f, 0.000124093771f, 0.000115478193f, 0.000107460779f};
__device__ __forceinline__ void p0_prologue(Frame& F) {
    unsigned* ctl = (unsigned*)(F.ws + WS_CTL);
    constexpr int NPUB = 18;
    if (F.vcu < NPUB) {
        const int row = F.vcu * NWAVES + F.wave;
        const float* c = row < 4 ? F.c_p + (size_t)row * D : F.c_s + (size_t)((row < NSEQ ? row : NSEQ - 1) - 4) * D;
        bf16* dst = WSP(bf16, WS_SILU) + (size_t)row * D;
#pragma unroll
        for (int j = 0; j < 4; ++j) { const int k = 8 * (F.lane + 64 * j);
            f32x4 c0 = *(const f32x4*)(c + k), c1 = *(const f32x4*)(c + k + 4);
            if (row >= NSEQ) { c0 = (f32x4){0.f, 0.f, 0.f, 0.f}; c1 = c0; }
            u32x4 p; p.x = pk2(silu_f(c0[0]), silu_f(c0[1])); p.y = pk2(silu_f(c0[2]), silu_f(c0[3])); p.z = pk2(silu_f(c1[0]), silu_f(c1[1])); p.w = pk2(silu_f(c1[2]), silu_f(c1[3]));
            *(u32x4*)(dst + k) = p; }
        VM_WAIT(); __syncthreads();
        if (F.tid == 0) { __builtin_amdgcn_fence(__ATOMIC_RELEASE, "agent"); VM_WAIT(); __hip_atomic_fetch_add(ctl + CW_SILU, 1u, __ATOMIC_RELAXED, __HIP_MEMORY_SCOPE_AGENT); }
    }
    LAS float* scr = (LAS float*)(F.lds + F.wave * 16384);
    if (F.mode == 2) {} else if (F.G == 256) { const int b = F.vcu; if (b >= 128) { const int start = (b - 128) * 128; transpose_range(F, start + F.wave, start + 128, NWAVES, scr); } }
    else transpose_range(F, F.vcu * NWAVES + F.wave, TR_P0_END, F.G * NWAVES, scr);
    float2* rope = WSP(float2, WS_ROPE);
    for (int idx = F.vcu * NTHREADS + F.tid; idx < 2056 * 128; idx += F.G * NTHREADS) {
        const int p = idx >> 7, i = idx & 127; const int pos = p < 2048 ? p : 16384 + (p - 2048);
        const float ang = (float)pos * ROPE_INV_FREQ[i];
        double t = (double)ang * 0.15915494309189535; t -= floor(t);
        const float f = (float)t;
        rope[idx] = make_float2(__builtin_amdgcn_cosf(f), __builtin_amdgcn_sinf(f)); }
#if defined(MK_STAMPS)
    if (F.tid == 0) ((unsigned long long*)(F.ws + ((size_t)901 << 20)) + (size_t)blockIdx.x * 64)[0] = __builtin_amdgcn_s_memrealtime();
#endif
    if (F.tid == 0) { unsigned sp = 0;
        while (__hip_atomic_load(ctl + CW_SILU, __ATOMIC_RELAXED, __HIP_MEMORY_SCOPE_AGENT) < (unsigned)(F.G < NPUB ? F.G : NPUB)) { __builtin_amdgcn_s_sleep(2); if (++sp > (1u << 22)) { atomicAdd(ctl + CW_BAR + XB_TMO, 1u); break; } }
        __builtin_amdgcn_fence(__ATOMIC_ACQUIRE, "agent"); VM_WAIT(); }
    __syncthreads();
#if defined(MK_STAMPS)
    unsigned long long* stq0 = (unsigned long long*)(F.ws + ((size_t)901 << 20)) + (size_t)blockIdx.x * 64;
    if (F.tid == 0) stq0[1] = __builtin_amdgcn_s_memrealtime();
    for (int it = F.vcu; it < 384; it += F.G) { ada_item(F, it); if (it == F.vcu && F.tid == 0) stq0[2] = __builtin_amdgcn_s_memrealtime(); }
#else
    if (F.mode != 1) for (int it = F.vcu; it < 384; it += F.G) ada_item(F, it);
#endif
}
template <int SRC, int NPARTS, bool XPF32>
__device__ __forceinline__ void norm_load_row(Frame& F, int lane, int r, f32x4 (&v)[8], const bf16* xcur_c, const void* xprev, const bf16* slab, const float* modl, int ig_prev, const float* pscale, bool& fixup) {
    fixup = false;
    if (SRC == 0) { const float* xr = r < MP ? F.x_p + (size_t)r * D : F.x_s + (size_t)(r - MP) * D;
#pragma unroll
        for (int j = 0; j < 8; ++j) v[j] = *(const f32x4*)(xr + 4 * (lane + 64 * j)); }
    else if (r < MP || NPARTS == 0) {
#pragma unroll
        for (int j = 0; j < 8; ++j) v[j] = ld_bf4(xcur_c + (size_t)r * D + 4 * (lane + 64 * j)); }
    else {
        fixup = true;
        const float* gate = modl + (size_t)seq_of(r) * NMOD + ig_prev * D;
#pragma unroll
        for (int j = 0; j < 8; ++j) { const int c = 4 * (lane + 64 * j);
            f32x4 sl[NPARTS > 0 ? NPARTS : 1];
#pragma unroll
            for (int p = 0; p < NPARTS; ++p) sl[p] = ld_bf4(slab + ((size_t)p * MS + (r - MP)) * D + c);
            const f32x4 xp = XPF32 ? *(const f32x4*)((const float*)xprev + (size_t)r * D + c) : ld_bf4((const bf16*)xprev + (size_t)r * D + c), gt = *(const f32x4*)(gate + c);
            f32x4 t = sl[0];
#pragma unroll
            for (int p = 1; p < NPARTS; ++p) t += sl[p];
            if (pscale) t *= *(const f32x4*)(pscale + c);
            v[j] = xp + gt * t;
            if ((j & 3) == 3) asm volatile("" ::: "memory"); }
    }
}
template <int SRC, int OUTMODE, int NPARTS, bool XPF32>
__device__ __forceinline__ void norm_rows(Frame& F, const bf16* xcur_c, bf16* xcur, const void* xprev, const bf16* slab, const float* modl, int ig_prev, const float* pscale,
                                          const float* g, int ish, int isc, bf16* A, float* yout) {
    const int gw = F.vcu * NWAVES + F.wave, NGW = F.G * NWAVES;
    int lane = F.lane; asm volatile("" : "+v"(lane));
    for (int r = gw; r < M; r += NGW) {
        const int s = seq_of(r);
        f32x4 v[8], gv[8], shv[8]; bool fix;
        norm_load_row<SRC, NPARTS, XPF32>(F, lane, r, v, xcur_c, xprev, slab, modl, ig_prev, pscale, fix);
        { const float* ms = modl + (size_t)s * NMOD;
#pragma unroll
          for (int j = 0; j < 8; ++j) { const int c = 4 * (lane + 64 * j);
              if (OUTMODE != 1) { const f32x4 gg = *(const f32x4*)(g + c), sc = *(const f32x4*)(ms + isc * D + c); gv[j] = gg * (sc + 1.0f); shv[j] = *(const f32x4*)(ms + ish * D + c); }
              else gv[j] = *(const f32x4*)(g + c); } }
        if (SRC == 1 && fix) {
#pragma unroll
            for (int j = 0; j < 8; ++j) { u32x2 w; w.x = pk2(v[j][0], v[j][1]); w.y = pk2(v[j][2], v[j][3]); *(u32x2*)(xcur + (size_t)r * D + 4 * (lane + 64 * j)) = w; } }
        float ss = 0.f;
#pragma unroll
        for (int j = 0; j < 8; ++j) ss += (v[j][0] * v[j][0] + v[j][1] * v[j][1]) + (v[j][2] * v[j][2] + v[j][3] * v[j][3]);
        const float rstd = 1.0f / sqrtf(wave_sum(ss) * (1.0f / D) + 1e-6f);
#pragma unroll
        for (int j = 0; j < 8; ++j) { const int c = 4 * (lane + 64 * j);
            f32x4 y = v[j] * rstd * gv[j];
            if (OUTMODE == 0 || OUTMODE == 2) {
                y = y + shv[j];
                if (OUTMODE == 0) { u32x2 w; w.x = pk2(y[0], y[1]); w.y = pk2(y[2], y[3]); *(u32x2*)(A + (size_t)r * D + c) = w; }
                else { y *= S_H2; *(unsigned*)((unsigned char*)A + (size_t)r * D + c) = pk4_fp8(y[0], y[1], y[2], y[3]); } }
            else *(f32x4*)(yout + (size_t)r * D + c) = y; }
    }
}
}
namespace pg8 {
using mk::bf16; using mk::bf16x8; using mk::f32x4; using mk::f32x2; using mk::u32x4; using mk::u32x2;
#define PG8_LAS __attribute__((address_space(3)))
constexpr int BM = 256, BK = 64, HALF = 128, HTB = HALF * BK * 2, STAGE_BYTES = 8 * HTB, NXCD = 8, WGM = 8;
__host__ __device__ __forceinline__ int lds_byte(int r, int c) { const int st = (r >> 4) * 2 + (c >> 5), rr = r & 15, cc = c & 31, ob = rr * 64 + cc * 2; return st * 1024 + (ob ^ (((ob >> 9) & 1) << 5)); }
__host__ __device__ __forceinline__ void stage_rc(int b, int& R, int& C) { const int st = b / 1024, sb = b % 1024, swz = sb ^ (((sb >> 9) & 1) << 5); R = (st >> 1) * 16 + swz / 64; C = (st & 1) * 32 + (swz % 64) / 2; }
__host__ __device__ __forceinline__ int perm32(int rho) { const int n = rho >> 4, i = rho & 15; return 8 * (i >> 2) + 4 * n + (i & 3); }

struct Unit { int pm, pn, ka, kb, nt, part; };
struct Gemm { const void* A; const void* Bt; int lda, ldb; };

struct OrdStatic {
    int nM, nN, nwg, G, c, nt;
    __device__ void init(int M_, int N_, int Kbytes, int G_, int c_) { nM = M_ / BM; nN = N_ / BM; nwg = nM * nN; G = G_; c = c_; nt = Kbytes / 128; }
    __device__ __forceinline__ bool next(int i, Unit& u) const {
        const long L = (long)i * G + c; if (L >= nwg) return false;
        int wgid = (int)L; { const int q = nwg / NXCD, r = nwg % NXCD, xcd = wgid % NXCD, off = wgid / NXCD; wgid = (xcd < r ? xcd * (q + 1) : r * (q + 1) + (xcd - r) * q) + off; }
        const int nig = WGM * nN, gid = wgid / nig, fm = gid * WGM, gsz = (nM - fm) < WGM ? (nM - fm) : WGM;
        u.pm = fm + ((wgid % nig) % gsz); u.pn = (wgid % nig) / gsz; u.ka = 0; u.kb = 0; u.nt = nt; u.part = -1; return true;
    }
};
struct OrdSplit {
    int G, c, ntfull, nparts, pool;
    __device__ void init(int Kbytes, int nparts_, int pool_, int G_, int c_) { G = G_; c = c_; ntfull = Kbytes / 128; nparts = nparts_; pool = pool_; }
    __device__ __forceinline__ bool next(int i, Unit& u) const {
        int ii = i; if (G == 256 && 32 * nparts == 256 && ((c >> 3) & 1)) { if (i > 1) return false; ii = 1 - i; }
        const int L = ii * G + c; if (L >= 256 + 32 * nparts) return false;
        const bool full = L < 256;
        const int j = L - 256, un = j / nparts, p = j - un * nparts;
        const int pm = full ? (L & 7) * 4 + (L >> 6) : 32 + (un >> 3);
        const int pn = full ? ((L >> 3) & 7) : (un & 7);
        const int q = (ntfull / 2) / nparts, r = (ntfull / 2) % nparts;
        const int ntp = 2 * (q + (p < r ? 1 : 0)), t0 = 2 * (p * q + (p < r ? p : r));
        const int kb = full ? 0 : 128 * t0;
        u.pm = pm; u.pn = pn; u.part = full ? -1 : p; u.kb = kb; u.nt = full ? ntfull : ntp; u.ka = kb + (pool ? 1024 * (pn >> 1) : 0);
        return true;
    }
};

struct EpiProj {
    static constexpr bool PERM = true;
    bf16 *Q, *K, *V, *G; const float2* rope;
    __device__ __forceinline__ void operator()(const f32x4 (&acc)[2][2][4][2], const Unit& u, int wr, int wc, int fr, int fq) const {
        const int row0 = u.pm * BM + wr * 64 + fr, cw = wc * 32 + 8 * fq;
        if (u.pn < 16) {
            const int h = u.pn & 7; const bool isq = u.pn < 8;
            bf16* dst = (isq ? Q : K) + h * 256 + cw;
            const float lg2 = log2f(1.0f - exp2f(-5.0f - (float)h));
#pragma unroll
            for (int ai = 0; ai < 2; ++ai)
#pragma unroll
                for (int m = 0; m < 4; ++m) {
                    const int r = row0 + ai * HALF + m * 16;
                    const int p = r < mk::MP ? (r & 2047) : 2048 + ((r - mk::MP) & 7), nn = r < mk::MP ? (r & 127) : ((r - mk::MP) & 7);
                    const float sc = isq ? exp2f((float)nn * lg2) : exp2f(-(float)nn * lg2) * 0.0625f;
                    const f32x4* tp = (const f32x4*)(rope + (size_t)p * 128 + cw);
                    const f32x4 t0 = tp[0], t1 = tp[1], t2 = tp[2], t3 = tp[3];
                    const f32x4 a0 = acc[ai][0][m][0], a1 = acc[ai][0][m][1], b0 = acc[ai][1][m][0], b1 = acc[ai][1][m][1];
                    f32x4 lo0, lo1, hi0, hi1;
                    lo0[0] = a0[0] * t0[0] - b0[0] * t0[1]; hi0[0] = a0[0] * t0[1] + b0[0] * t0[0];
                    lo0[1] = a0[1] * t0[2] - b0[1] * t0[3]; hi0[1] = a0[1] * t0[3] + b0[1] * t0[2];
                    lo0[2] = a0[2] * t1[0] - b0[2] * t1[1]; hi0[2] = a0[2] * t1[1] + b0[2] * t1[0];
                    lo0[3] = a0[3] * t1[2] - b0[3] * t1[3]; hi0[3] = a0[3] * t1[3] + b0[3] * t1[2];
                    lo1[0] = a1[0] * t2[0] - b1[0] * t2[1]; hi1[0] = a1[0] * t2[1] + b1[0] * t2[0];
                    lo1[1] = a1[1] * t2[2] - b1[1] * t2[3]; hi1[1] = a1[1] * t2[3] + b1[1] * t2[2];
                    lo1[2] = a1[2] * t3[0] - b1[2] * t3[1]; hi1[2] = a1[2] * t3[1] + b1[2] * t3[0];
                    lo1[3] = a1[3] * t3[2] - b1[3] * t3[3]; hi1[3] = a1[3] * t3[3] + b1[3] * t3[2];
                    lo0 *= sc; lo1 *= sc; hi0 *= sc; hi1 *= sc;
                    u32x4 w; w.x = mk::pk2(lo0[0], lo0[1]); w.y = mk::pk2(lo0[2], lo0[3]); w.z = mk::pk2(lo1[0], lo1[1]); w.w = mk::pk2(lo1[2], lo1[3]);
                    *(u32x4*)(dst + (size_t)r * 2048) = w;
                    w.x = mk::pk2(hi0[0], hi0[1]); w.y = mk::pk2(hi0[2], hi0[3]); w.z = mk::pk2(hi1[0], hi1[1]); w.w = mk::pk2(hi1[2], hi1[3]);
                    *(u32x4*)(dst + (size_t)r * 2048 + 128) = w;
                }
        } else {
            const bool isv = u.pn < 32;
            bf16* dst = (isv ? V + (u.pn - 16) * 256 : G + (u.pn - 32) * 256) + cw;
#pragma unroll
            for (int ai = 0; ai < 2; ++ai)
#pragma unroll
                for (int m = 0; m < 4; ++m) { bf16* rowp = dst + (size_t)(row0 + ai * HALF + m * 16) * 4096;
                    float e[16];
                    if (!isv) {
#pragma unroll
                        for (int q = 0; q < 16; ++q) e[q] = __builtin_amdgcn_exp2f(-1.44269504089f * acc[ai][q >> 3][m][(q >> 2) & 1][q & 3]);
                        asm volatile("" : "+v"(e[0]), "+v"(e[1]), "+v"(e[2]), "+v"(e[3]), "+v"(e[4]), "+v"(e[5]), "+v"(e[6]), "+v"(e[7]), "+v"(e[8]), "+v"(e[9]), "+v"(e[10]), "+v"(e[11]), "+v"(e[12]), "+v"(e[13]), "+v"(e[14]), "+v"(e[15]));
#pragma unroll
                        for (int q = 0; q < 16; ++q) e[q] = __builtin_amdgcn_rcpf(1.0f + e[q]);
                        asm volatile("" : "+v"(e[0]), "+v"(e[1]), "+v"(e[2]), "+v"(e[3]), "+v"(e[4]), "+v"(e[5]), "+v"(e[6]), "+v"(e[7]), "+v"(e[8]), "+v"(e[9]), "+v"(e[10]), "+v"(e[11]), "+v"(e[12]), "+v"(e[13]), "+v"(e[14]), "+v"(e[15])); }
#pragma unroll
                    for (int bj = 0; bj < 2; ++bj) { f32x4 v0 = acc[ai][bj][m][0], v1 = acc[ai][bj][m][1];
                        if (!isv) {
#pragma unroll
                            for (int j = 0; j < 4; ++j) { v0[j] *= e[8 * bj + j]; v1[j] *= e[8 * bj + 4 + j]; } }
                        u32x4 w; w.x = mk::pk2(v0[0], v0[1]); w.y = mk::pk2(v0[2], v0[3]); w.z = mk::pk2(v1[0], v1[1]); w.w = mk::pk2(v1[2], v1[3]);
                        *(u32x4*)(rowp + bj * HALF) = w; } }
        }
    }
};
template <bool F8> struct EpiSwiglu {
    static constexpr bool PERM = true;
    void* H;
#if MK_EXPERIMENT
    int xmode;
#endif
    __device__ __forceinline__ void operator()(const f32x4 (&acc)[2][2][4][2], const Unit& u, int wr, int wc, int fr, int fq) const {
#if MK_EXPERIMENT
        if (xmode == 6) return;
#endif
        const int row0 = u.pm * BM + wr * 64 + fr; const int col = u.pn * 128 + wc * 32 + 8 * fq;
        const float si = F8 ? 1.0f / (mk::S_H2 * mk::S_W1) : 1.0f;
#pragma unroll
        for (int ai = 0; ai < 2; ++ai)
#pragma unroll
            for (int mp = 0; mp < 2; ++mp) { float gg[16], uu[16], e[16];
#pragma unroll
                for (int q = 0; q < 16; ++q) { const int m = 2 * mp + (q >> 3), n = (q >> 2) & 1, j = q & 3; gg[q] = acc[ai][0][m][n][j] * si; uu[q] = acc[ai][1][m][n][j] * si; }
#if MK_EXPERIMENT
                if (xmode == 5) {
#pragma unroll
                    for (int q = 0; q < 16; ++q) e[q] = 1.0f; } else
#endif
                {
#pragma unroll
                for (int q = 0; q < 16; ++q) e[q] = __builtin_amdgcn_exp2f(-1.44269504089f * gg[q]);
                asm volatile("" : "+v"(e[0]), "+v"(e[1]), "+v"(e[2]), "+v"(e[3]), "+v"(e[4]), "+v"(e[5]), "+v"(e[6]), "+v"(e[7]), "+v"(e[8]), "+v"(e[9]), "+v"(e[10]), "+v"(e[11]), "+v"(e[12]), "+v"(e[13]), "+v"(e[14]), "+v"(e[15]));
#pragma unroll
                for (int q = 0; q < 16; ++q) e[q] = __builtin_amdgcn_rcpf(1.0f + e[q]);
                asm volatile("" : "+v"(e[0]), "+v"(e[1]), "+v"(e[2]), "+v"(e[3]), "+v"(e[4]), "+v"(e[5]), "+v"(e[6]), "+v"(e[7]), "+v"(e[8]), "+v"(e[9]), "+v"(e[10]), "+v"(e[11]), "+v"(e[12]), "+v"(e[13]), "+v"(e[14]), "+v"(e[15])); }
#pragma unroll
                for (int mm = 0; mm < 2; ++mm) { const int m = 2 * mp + mm; f32x4 v0, v1;
#pragma unroll
                    for (int j = 0; j < 4; ++j) { v0[j] = gg[8 * mm + j] * e[8 * mm + j] * uu[8 * mm + j]; v1[j] = gg[8 * mm + 4 + j] * e[8 * mm + 4 + j] * uu[8 * mm + 4 + j]; }
                    const size_t off = (size_t)(row0 + ai * HALF + m * 16) * mk::FF + col;
                    if (F8) { v0 *= mk::S_HID; v1 *= mk::S_HID; u32x2 w; w.x = mk::pk4_fp8(v0[0], v0[1], v0[2], v0[3]); w.y = mk::pk4_fp8(v1[0], v1[1], v1[2], v1[3]);
#if MK_EXPERIMENT
                        if (xmode == 4 && (w.x ^ w.y) != 0x13572468u) continue;
#endif
                        *(u32x2*)((unsigned char*)H + off) = w; }
                    else { u32x4 w; w.x = mk::pk2(v0[0], v0[1]); w.y = mk::pk2(v0[2], v0[3]); w.z = mk::pk2(v1[0], v1[1]); w.w = mk::pk2(v1[2], v1[3]); *(u32x4*)((bf16*)H + off) = w; } } }
    }
};
template <int MODE, bool XIF32> struct EpiResid {
    static constexpr bool PERM = true;
    const void* xi; bf16* xo; const float* gate  ; bf16* slab; float* extra; float ascale  ;
    __device__ __forceinline__ void operator()(const f32x4 (&acc)[2][2][4][2], const Unit& u, int wr, int wc, int fr, int fq) const {
        const int row0 = u.pm * BM + wr * 64 + fr, col0 = u.pn * BM + wc * 32 + 8 * fq;
        if (u.part >= 0) {
            bf16* sp = slab + ((ptrdiff_t)u.part * mk::MS - mk::MP) * (ptrdiff_t)mk::D + col0;
#pragma unroll
            for (int ai = 0; ai < 2; ++ai)
#pragma unroll
                for (int m = 0; m < 4; ++m) { bf16* rowp = sp + (ptrdiff_t)(row0 + ai * HALF + m * 16) * mk::D;
#pragma unroll
                    for (int bj = 0; bj < 2; ++bj) { const f32x4 v0 = acc[ai][bj][m][0] * ascale, v1 = acc[ai][bj][m][1] * ascale;
                        u32x4 w; w.x = mk::pk2(v0[0], v0[1]); w.y = mk::pk2(v0[2], v0[3]); w.z = mk::pk2(v1[0], v1[1]); w.w = mk::pk2(v1[2], v1[3]); *(u32x4*)(rowp + bj * HALF) = w; } }
            return;
        }
#pragma unroll
        for (int ai = 0; ai < 2; ++ai)
#pragma unroll
            for (int m = 0; m < 4; ++m) { const int r = row0 + ai * HALF + m * 16; const size_t off = (size_t)r * mk::D + col0; const float* gp = gate + (size_t)mk::seq_of(r) * mk::NMOD + col0;
                float ss = 0.f;
#pragma unroll
                for (int bj = 0; bj < 2; ++bj) { const int o = bj * HALF;
                    f32x4 x0, x1;
                    if constexpr (XIF32) { x0 = *(const f32x4*)((const float*)xi + off + o); x1 = *(const f32x4*)((const float*)xi + off + o + 4); }
                    else { const u32x4 w = *(const u32x4*)((const bf16*)xi + off + o);
                        x0 = (f32x4){__uint_as_float(w.x << 16), __uint_as_float(w.x & 0xffff0000u), __uint_as_float(w.y << 16), __uint_as_float(w.y & 0xffff0000u)};
                        x1 = (f32x4){__uint_as_float(w.z << 16), __uint_as_float(w.z & 0xffff0000u), __uint_as_float(w.w << 16), __uint_as_float(w.w & 0xffff0000u)}; }
                    f32x4 v0 = acc[ai][bj][m][0] * ascale, v1 = acc[ai][bj][m][1] * ascale;
                    if constexpr (MODE == 1) { v0 *= *(const f32x4*)(extra + col0 + o); v1 *= *(const f32x4*)(extra + col0 + o + 4); }
                    const f32x4 y0 = x0 + *(const f32x4*)(gp + o) * v0, y1 = x1 + *(const f32x4*)(gp + o + 4) * v1;
                    u32x4 w; w.x = mk::pk2(y0[0], y0[1]); w.y = mk::pk2(y0[2], y0[3]); w.z = mk::pk2(y1[0], y1[1]); w.w = mk::pk2(y1[2], y1[3]); *(u32x4*)(xo + off + o) = w;
                    if constexpr (MODE == 2) ss += ((y0[0] * y0[0] + y0[1] * y0[1]) + (y0[2] * y0[2] + y0[3] * y0[3])) + ((y1[0] * y1[0] + y1[1] * y1[1]) + (y1[2] * y1[2] + y1[3] * y1[3])); }
                if constexpr (MODE == 2) { ss += __shfl_xor(ss, 16); ss += __shfl_xor(ss, 32); if (fq == 0) __hip_atomic_fetch_add(extra + r, ss, __ATOMIC_RELAXED, __HIP_MEMORY_SCOPE_AGENT); }
                asm volatile("" ::: "memory"); }
    }
};

typedef int i32x4 __attribute__((ext_vector_type(4)));
typedef int i32x8 __attribute__((ext_vector_type(8)));
template <bool F8> struct FragT;
template <> struct FragT<false> { bf16x8 k0, k1; };
template <> struct FragT<true>  { i32x8 v; };
template <bool F8> __device__ __forceinline__ void frag_load(FragT<F8>& f, const PG8_LAS unsigned char* p) {
    if constexpr (F8) { f.v.lo = *(const PG8_LAS i32x4*)p; f.v.hi = *(const PG8_LAS i32x4*)(p + 1024); }
    else { f.k0 = *(const PG8_LAS bf16x8*)p; f.k1 = *(const PG8_LAS bf16x8*)(p + 1024); }
}
template <bool F8> __device__ __forceinline__ void frag_mma(f32x4& acc, const FragT<F8>& b, const FragT<F8>& a) {
    if constexpr (F8) {
        const int sc = 0x7F7F7F7F;
#if defined(__HIP_DEVICE_COMPILE__)
        asm volatile("v_mfma_scale_f32_16x16x128_f8f6f4 %0, %1, %2, %0, %3, %3 op_sel_hi:[0,0,0]" : "+v"(acc) : "v"(b.v), "v"(a.v), "v"(sc));
#else
        (void)sc;
#endif
    }
    else { acc = __builtin_amdgcn_mfma_f32_16x16x32_bf16(b.k0, a.k0, acc, 0, 0, 0); acc = __builtin_amdgcn_mfma_f32_16x16x32_bf16(b.k1, a.k1, acc, 0, 0, 0); }
}
template <bool F8, class Epi, class Sched>
__device__ __forceinline__ void gemm_phase(PG8_LAS unsigned char* lds, const Gemm g, const Sched& S, const Epi& E
#if defined(MK_STAMPS)
    , unsigned long long* stq = nullptr
#endif
    ) {
#if defined(MK_STAMPS)
    unsigned long long st_kl = 0, st_epi = 0, st_a = 0, st_b = 0, st_eo = 0; unsigned st_nt = 0, st_nu = 0;
#endif
    const int tid = threadIdx.x, wid = __builtin_amdgcn_readfirstlane(tid >> 6), lane = tid & 63, wr = wid >> 2, wc = wid & 3, fr = lane & 15, fq = lane >> 4;
    unsigned voffA[2], voffB[2];
#pragma unroll
    for (int i = 0; i < 2; ++i) { int R, C; stage_rc(tid * 16 + i * 8192, R, C); const int Rb = Epi::PERM ? ((R & ~31) + perm32(R & 31)) : R;
        voffA[i] = (unsigned)(R * g.lda + C * 2); voffB[i] = (unsigned)(Rb * g.ldb + C * 2); }
    const size_t kstep = (size_t)(BK * 2);
    const size_t hstepA = (size_t)HALF * g.lda, hstepB = (size_t)HALF * g.ldb;
    const unsigned ldsw = (unsigned)wid * 1024u;
    const int aoff = lds_byte(wr * 64 + fr, fq * 8), boff = lds_byte(wc * 32 + fr, fq * 8);
#define PG8_SA(b, h) (((b) * 2 + (h)) * HTB)
#define PG8_SB(b, h) ((4 + (b) * 2 + (h)) * HTB)
#define PG8_STAGE(bufoff, gbase, voff) do { _Pragma("unroll") for (int _i = 0; _i < 2; ++_i) \
        __builtin_amdgcn_global_load_lds((const unsigned*)((const char*)(gbase) + (voff)[_i]), (PG8_LAS unsigned*)(lds + (bufoff) + ldsw + _i * 8192), 16, 0, 0); } while (0)
#define PG8_LDA(dst, b, h) do { _Pragma("unroll") for (int m = 0; m < 4; ++m) frag_load<F8>(dst[m], lds + PG8_SA(b, h) + aoff + m * 2048); } while (0)
#define PG8_LDB(dst, b, h) do { _Pragma("unroll") for (int n = 0; n < 2; ++n) frag_load<F8>(dst[n], lds + PG8_SB(b, h) + boff + n * 2048); } while (0)
#define PG8_MMA(ai, bj, At, Bt) do { __builtin_amdgcn_s_setprio(1); _Pragma("unroll") for (int m = 0; m < 4; ++m) _Pragma("unroll") for (int n = 0; n < 2; ++n) frag_mma<F8>(acc[ai][bj][m][n], Bt[n], At[m]); \
        __builtin_amdgcn_s_setprio(0); } while (0)
#define PG8_WAIT_V(n) asm volatile("s_waitcnt vmcnt(" #n ")" ::: "memory")
#define PG8_WAIT_L(n) asm volatile("s_waitcnt lgkmcnt(" #n ")" ::: "memory")
#define PG8_BAR __builtin_amdgcn_s_barrier()
#define PG8_SCHED __builtin_amdgcn_sched_barrier(0)
    Unit cur, nxt; int ui = 0;
    if (!S.next(0, cur)) return;
    f32x4 acc[2][2][4][2];
#pragma unroll
    for (int a = 0; a < 2; ++a)
#pragma unroll
        for (int b = 0; b < 2; ++b)
#pragma unroll
            for (int m = 0; m < 4; ++m)
#pragma unroll
                for (int n = 0; n < 2; ++n) acc[a][b][m][n] = (f32x4){0.f, 0.f, 0.f, 0.f};
    FragT<F8> At[4], B0[2], B1[2];
    const char* cA = (const char*)g.A + (size_t)cur.pm * 2 * hstepA + (size_t)cur.ka; const char* cB = (const char*)g.Bt + (size_t)cur.pn * 2 * hstepB + (size_t)cur.kb;
    PG8_STAGE(PG8_SB(0, 0), cB, voffB); PG8_STAGE(PG8_SB(0, 1), cB + hstepB, voffB); PG8_STAGE(PG8_SA(0, 0), cA, voffA); PG8_STAGE(PG8_SA(0, 1), cA + hstepA, voffA);
    if (wr == 1) PG8_BAR;
    PG8_WAIT_V(2); PG8_BAR;
    PG8_STAGE(PG8_SB(1, 0), cB + kstep, voffB); PG8_STAGE(PG8_SA(1, 0), cA + kstep, voffA); PG8_STAGE(PG8_SB(1, 1), cB + hstepB + kstep, voffB);
    PG8_WAIT_V(6); PG8_BAR;
    for (;;) {
        const bool has_next = S.next(ui + 1, nxt);
        const char* nA = has_next ? (const char*)g.A + (size_t)nxt.pm * 2 * hstepA + (size_t)nxt.ka : cA; const char* nB = has_next ? (const char*)g.Bt + (size_t)nxt.pn * 2 * hstepB + (size_t)nxt.kb : cB;
        const int nt = cur.nt;
#if defined(MK_STAMPS)
        st_a = __builtin_amdgcn_s_memrealtime(); if (st_nu) st_epi += st_a - st_b;
#endif
        for (int t = 0; t < nt; t += 2) {
            const bool last = (t == nt - 2);
            const char* a1 = cA + (size_t)(t + 1) * kstep;
            const char* a2 = last ? nA : cA + (size_t)(t + 2) * kstep; const char* b2 = last ? nB : cB + (size_t)(t + 2) * kstep;
            const char* a3 = a2 + kstep; const char* b3 = b2 + kstep;
            PG8_LDB(B0, 0, 0); PG8_LDB(B1, 0, 1); PG8_SCHED; PG8_LDA(At, 0, 0); PG8_STAGE(PG8_SA(1, 1), a1 + hstepA, voffA);
            PG8_WAIT_V(8); PG8_WAIT_L(0); PG8_BAR; PG8_MMA(0, 0, At, B0); PG8_MMA(0, 1, At, B1); PG8_BAR; PG8_SCHED;
            PG8_LDA(At, 0, 1); PG8_STAGE(PG8_SB(0, 0), b2, voffB); PG8_STAGE(PG8_SB(0, 1), b2 + hstepB, voffB); PG8_STAGE(PG8_SA(0, 0), a2, voffA);
            PG8_WAIT_V(8); PG8_WAIT_L(0); PG8_BAR; PG8_MMA(1, 0, At, B0); PG8_MMA(1, 1, At, B1); PG8_BAR; PG8_SCHED;
            PG8_LDB(B0, 1, 0); PG8_LDB(B1, 1, 1); PG8_SCHED; PG8_LDA(At, 1, 0); PG8_STAGE(PG8_SA(0, 1), a2 + hstepA, voffA);
            PG8_WAIT_V(8); PG8_WAIT_L(0); PG8_BAR; PG8_MMA(0, 0, At, B0); PG8_MMA(0, 1, At, B1); PG8_BAR; PG8_SCHED;
            PG8_LDA(At, 1, 1); PG8_STAGE(PG8_SB(1, 0), b3, voffB); PG8_STAGE(PG8_SB(1, 1), b3 + hstepB, voffB); PG8_STAGE(PG8_SA(1, 0), a3, voffA);
            PG8_WAIT_V(8); PG8_WAIT_L(0); PG8_BAR; PG8_MMA(1, 0, At, B0); PG8_MMA(1, 1, At, B1); PG8_BAR; PG8_SCHED;
        }
#if defined(MK_STAMPS)
        st_b = __builtin_amdgcn_s_memrealtime(); st_kl += st_b - st_a; st_nt += (unsigned)nt; ++st_nu;
#endif
        if (wr == 0) PG8_BAR;
        if constexpr (F8) asm volatile("s_nop 15\n\ts_nop 15" ::: "memory");
#if defined(MK_STAMPS)
        const unsigned long long st_e0 = __builtin_amdgcn_s_memrealtime();
#endif
        E(acc, cur, wr, wc, fr, fq);
#if defined(MK_STAMPS)
        __builtin_amdgcn_sched_barrier(0); st_eo += __builtin_amdgcn_s_memrealtime() - st_e0;
#endif
        if (!has_next) break;
#pragma unroll
        for (int a = 0; a < 2; ++a)
#pragma unroll
            for (int b = 0; b < 2; ++b)
#pragma unroll
                for (int m = 0; m < 4; ++m)
#pragma unroll
                    for (int n = 0; n < 2; ++n) acc[a][b][m][n] = (f32x4){0.f, 0.f, 0.f, 0.f};
        cur = nxt; cA = nA; cB = nB; ++ui;
        if (wr == 1) PG8_BAR;
    }
#if defined(MK_STAMPS)
    st_epi += __builtin_amdgcn_s_memrealtime() - st_b;
    if (stq && tid == 0) { stq[0] = st_kl; stq[1] = st_epi; stq[2] = st_nt; stq[3] = (unsigned long long)st_nu | (st_eo << 8); }
#endif
    PG8_WAIT_V(0);
    PG8_BAR;
#undef PG8_SA
#undef PG8_SB
#undef PG8_STAGE
#undef PG8_LDA
#undef PG8_LDB
#undef PG8_MMA
#undef PG8_WAIT_V
#undef PG8_WAIT_L
#undef PG8_BAR
#undef PG8_SCHED
}
}
namespace mk {
__device__ __forceinline__ s16x4 tr16(const LAS unsigned char* p) { return __builtin_bit_cast(s16x4, __builtin_amdgcn_ds_read_tr16_b64_v4i16((LAS v4i16_t*)p)); }
__device__ __forceinline__ bf16x8 cat8(s16x4 lo, s16x4 hi) { return __builtin_shufflevector(lo, hi, 0, 1, 2, 3, 4, 5, 6, 7); }
#define LBAR() do { asm volatile("s_waitcnt lgkmcnt(0)" ::: "memory"); __builtin_amdgcn_s_barrier(); asm volatile("" ::: "memory"); } while (0)

constexpr int KT_OFF = 0, KT_ROW = 544, VT_OFF = 128 * KT_ROW  , VT_ROW = 160, SD_OFF = VT_OFF + 128 * VT_ROW  , SD_ROW = 160;
static_assert(SD_OFF + 256 * SD_ROW == 131072, "retention LDS map");

__device__ __forceinline__ void ret_prompt_item(Frame& F, int item) {
    const int b = item >> 6, h = (item >> 3) & 7, sl = item & 7;
    const int w = F.wave, lane = F.lane, fr = lane & 15, fq = lane >> 4, tq = (lane & 15) >> 2, tp = lane & 3;
    const int ns = w < 4 ? w : 11 - w;
    const float gam = 1.0f - exp2f(-5.0f - (float)h);
    const float g127 = exp2f(127.0f * log2f(gam));
    const bf16* Qg = WSP(bf16, WS_Q) + (size_t)(b * 2048) * D + h * DK;
    const bf16* Kg = WSP(bf16, WS_K) + (size_t)(b * 2048) * D + h * DK;
    const bf16* Vg = WSP(bf16, WS_V) + (size_t)(b * 2048) * HV + h * DV + sl * 64;
    bf16* Og = WSP(bf16, WS_O) + (size_t)(b * 2048) * HV + h * DV + sl * 64;
    LAS unsigned char* lds = F.lds;
    f32x4 sacc[4][2];
#pragma unroll
    for (int a = 0; a < 4; ++a)
#pragma unroll
        for (int d = 0; d < 2; ++d) sacc[a][d] = (f32x4){0.f, 0.f, 0.f, 0.f};
    u32x4 kreg[8], vreg[2];
#pragma unroll
    for (int i = 0; i < 8; ++i) { const int idx = F.tid + 512 * i, row = idx >> 5, c16 = idx & 31; kreg[i] = *(const u32x4*)(Kg + (size_t)row * D + 8 * c16); }
#pragma unroll
    for (int i = 0; i < 2; ++i) { const int idx = F.tid + 512 * i, row = idx >> 3, c16 = idx & 7; vreg[i] = *(const u32x4*)(Vg + (size_t)row * HV + 8 * c16); }
    LBAR();
#pragma unroll
    for (int i = 0; i < 8; ++i) { const int idx = F.tid + 512 * i, row = idx >> 5, c16 = idx & 31; *(LAS u32x4*)(lds + KT_OFF + row * KT_ROW + c16 * 16) = kreg[i]; }
#pragma unroll
    for (int i = 0; i < 2; ++i) { const int idx = F.tid + 512 * i, row = idx >> 3, c16 = idx & 7; *(LAS u32x4*)(lds + VT_OFF + row * VT_ROW + c16 * 16) = vreg[i]; }
    for (int c = 0; c < 16; ++c) {
        const int t0 = 128 * c;
        bf16x8 qf[8];
        { const bf16* qp = Qg + (size_t)(t0 + 16 * ns + fr) * D + 8 * fq;
#pragma unroll
          for (int ks = 0; ks < 8; ++ks) qf[ks] = *(const bf16x8*)(qp + 32 * ks); }
        LBAR();
        { const int cn = c + 1 < 16 ? c + 1 : c; const bf16* kp = Kg + (size_t)(128 * cn) * D; const bf16* vp = Vg + (size_t)(128 * cn) * HV;
#pragma unroll
          for (int i = 0; i < 8; ++i) { const int idx = F.tid + 512 * i, row = idx >> 5, c16 = idx & 31; kreg[i] = *(const u32x4*)(kp + (size_t)row * D + 8 * c16); }
#pragma unroll
          for (int i = 0; i < 2; ++i) { const int idx = F.tid + 512 * i, row = idx >> 3, c16 = idx & 7; vreg[i] = *(const u32x4*)(vp + (size_t)row * HV + 8 * c16); } }
#pragma unroll
        for (int a = 0; a < 4; ++a)
#pragma unroll
            for (int d = 0; d < 2; ++d) sacc[a][d] *= gam;
#pragma unroll
        for (int ks = 0; ks < 4; ++ks) {
            bf16x8 bk[2];
#pragma unroll
            for (int dt = 0; dt < 2; ++dt) { const LAS unsigned char* p = lds + KT_OFF + (32 * ks + 4 * fq + tq) * KT_ROW + (32 * w + 16 * dt + 4 * tp) * 2; bk[dt] = cat8(tr16(p), tr16(p + 16 * KT_ROW)); }
#pragma unroll
            for (int et = 0; et < 4; ++et) {
                const LAS unsigned char* p = lds + VT_OFF + (32 * ks + 4 * fq + tq) * VT_ROW + (16 * et + 4 * tp) * 2;
                const bf16x8 a = cat8(tr16(p), tr16(p + 16 * VT_ROW));
#pragma unroll
                for (int dt = 0; dt < 2; ++dt) sacc[et][dt] = __builtin_amdgcn_mfma_f32_16x16x32_bf16(a, bk[dt], sacc[et][dt], 0, 0, 0);
            }
        }
#pragma unroll
        for (int a = 0; a < 4; ++a)
#pragma unroll
            for (int d = 0; d < 2; ++d) sacc[a][d] *= g127;
        f32x4 oacc[4];
#pragma unroll
        for (int et = 0; et < 4; ++et) oacc[et] = (f32x4){0.f, 0.f, 0.f, 0.f};
        if (c > 0) {
#pragma unroll
            for (int ks = 0; ks < 8; ++ks)
#pragma unroll
                for (int et = 0; et < 4; ++et) {
                    const LAS unsigned char* p = lds + SD_OFF + (32 * ks + 8 * fq + tq) * SD_ROW + (16 * et + 4 * tp) * 2;
                    const bf16x8 a = cat8(tr16(p), tr16(p + 4 * SD_ROW));
                    oacc[et] = __builtin_amdgcn_mfma_f32_16x16x32_bf16(a, qf[ks], oacc[et], 0, 0, 0);
                }
#pragma unroll
            for (int et = 0; et < 4; ++et) oacc[et] *= gam;
        }
        for (int u2 = 0; 2 * u2 <= ns; ++u2) {
            const int mt0 = 2 * u2, mt1 = 2 * u2 + 1;
            f32x4 st0 = (f32x4){0.f, 0.f, 0.f, 0.f}, st1 = st0;
            { const LAS unsigned char* ka = lds + KT_OFF + (16 * mt0 + fr) * KT_ROW + 16 * fq;
#pragma unroll
              for (int ks = 0; ks < 8; ++ks) { const bf16x8 a = *(const LAS bf16x8*)(ka + 64 * ks); st0 = __builtin_amdgcn_mfma_f32_16x16x32_bf16(a, qf[ks], st0, 0, 0, 0); } }
            if (mt1 <= ns) { const LAS unsigned char* ka = lds + KT_OFF + (16 * mt1 + fr) * KT_ROW + 16 * fq;
#pragma unroll
              for (int ks = 0; ks < 8; ++ks) { const bf16x8 a = *(const LAS bf16x8*)(ka + 64 * ks); st1 = __builtin_amdgcn_mfma_f32_16x16x32_bf16(a, qf[ks], st1, 0, 0, 0); } }
#pragma unroll
            for (int j = 0; j < 4; ++j) { if (mt0 == ns && 4 * fq + j > fr) st0[j] = 0.f; if (mt1 > ns || (mt1 == ns && 4 * fq + j > fr)) st1[j] = 0.f; }
            u32x4 pp; pp.x = pk2(st0[0], st0[1]); pp.y = pk2(st0[2], st0[3]); pp.z = pk2(st1[0], st1[1]); pp.w = pk2(st1[2], st1[3]);
            const bf16x8 pb = __builtin_bit_cast(bf16x8, pp);
#pragma unroll
            for (int et = 0; et < 4; ++et) {
                const LAS unsigned char* p = lds + VT_OFF + (16 * mt0 + 4 * fq + tq) * VT_ROW + (16 * et + 4 * tp) * 2;
                const bf16x8 a = cat8(tr16(p), tr16(p + 16 * VT_ROW));
                oacc[et] = __builtin_amdgcn_mfma_f32_16x16x32_bf16(a, pb, oacc[et], 0, 0, 0);
            }
        }
        { bf16* op = Og + (size_t)(t0 + 16 * ns + fr) * HV + 4 * fq;
#pragma unroll
          for (int et = 0; et < 4; ++et) { u32x2 o2; o2.x = pk2(oacc[et][0], oacc[et][1]); o2.y = pk2(oacc[et][2], oacc[et][3]); *(u32x2*)(op + 16 * et) = o2; } }
        LBAR();
#pragma unroll
        for (int et = 0; et < 4; ++et)
#pragma unroll
            for (int dt = 0; dt < 2; ++dt) { u32x2 o2; o2.x = pk2(sacc[et][dt][0], sacc[et][dt][1]); o2.y = pk2(sacc[et][dt][2], sacc[et][dt][3]);
                *(LAS u32x2*)(lds + SD_OFF + (32 * w + 16 * dt + fr) * SD_ROW + (16 * et + 4 * fq) * 2) = o2; }
#pragma unroll
        for (int i = 0; i < 8; ++i) { const int idx = F.tid + 512 * i, row = idx >> 5, c16 = idx & 31; *(LAS u32x4*)(lds + KT_OFF + row * KT_ROW + c16 * 16) = kreg[i]; }
#pragma unroll
        for (int i = 0; i < 2; ++i) { const int idx = F.tid + 512 * i, row = idx >> 3, c16 = idx & 7; *(LAS u32x4*)(lds + VT_OFF + row * VT_ROW + c16 * 16) = vreg[i]; }
    }
    { float* sp = F.sr_p + ((size_t)(b * NH + h) * DK) * DV + sl * 64;
#pragma unroll
      for (int et = 0; et < 4; ++et)
#pragma unroll
          for (int dt = 0; dt < 2; ++dt) *(f32x4*)(sp + (size_t)(32 * w + 16 * dt + fr) * DV + 16 * et + 4 * fq) = sacc[et][dt]; }
    LBAR();
}

constexpr int SQ_OFF = 0, SK_OFF = 8 * 260 * 4, SV_OFF = SK_OFF + 256 * 8 * 4, SPART_OFF = SV_OFF + 8 * 512 * 4, SPM_OFF = SPART_OFF + 512 * 4;
__device__ __forceinline__ void ret_sample_item(Frame& F, int item) {
    const int b = item >> 3, h = item & 7, w = F.wave, lane = F.lane, fr = lane & 15, fq = lane >> 4, tid = F.tid;
    const float gam = 1.0f - exp2f(-5.0f - (float)h);
    const float g7 = exp2f(7.0f * log2f(gam)), g8 = g7 * gam;
    const int r0 = MP + 8 * b;
    LAS float* qs = (LAS float*)(F.lds + SQ_OFF); LAS float* kt = (LAS float*)(F.lds + SK_OFF); LAS float* vs = (LAS float*)(F.lds + SV_OFF);
    LAS float* part = (LAS float*)(F.lds + SPART_OFF); LAS float* pm = (LAS float*)(F.lds + SPM_OFF);
    const int e4 = 64 * w + 4 * fr;
    const float* S0 = F.state_ret + ((size_t)(b * NH + h) * DK + fq) * DV + e4;
    float* S1 = F.sr_s + ((size_t)(b * NH + h) * DK + fq) * DV + e4;
    f32x4 sa[8], sb[8];
    const int tq8 = (tid & 255) >> 5, d0 = 8 * (tid & 31); const bool isq = tid < 256;
    const u32x4 rawqk = *(const u32x4*)((isq ? WSP(bf16, WS_Q) : WSP(bf16, WS_K)) + (size_t)(r0 + tq8) * D + h * DK + d0);
    const int tv = tid >> 6, e0 = 8 * (tid & 63);
    const u32x4 rawv = *(const u32x4*)(WSP(bf16, WS_V) + (size_t)(r0 + tv) * HV + h * DV + e0);
#pragma unroll
    for (int u = 0; u < 8; ++u) sa[u] = __builtin_nontemporal_load((const f32x4*)(S0 + (size_t)(4 * u) * DV));
    LBAR();
    { float f[8];
#pragma unroll
      for (int i = 0; i < 4; ++i) { f[2 * i] = __uint_as_float(rawqk[i] << 16); f[2 * i + 1] = __uint_as_float(rawqk[i] & 0xffff0000u); }
      if (isq) { *(LAS f32x4*)(qs + tq8 * 260 + d0) = (f32x4){f[0], f[1], f[2], f[3]}; *(LAS f32x4*)(qs + tq8 * 260 + d0 + 4) = (f32x4){f[4], f[5], f[6], f[7]}; }
      else {
#pragma unroll
          for (int i = 0; i < 8; ++i) kt[(d0 + i) * 8 + tq8] = f[i]; } }
    { f32x4 lo, hi;
#pragma unroll
      for (int i = 0; i < 2; ++i) { lo[2 * i] = __uint_as_float(rawv[i] << 16); lo[2 * i + 1] = __uint_as_float(rawv[i] & 0xffff0000u); hi[2 * i] = __uint_as_float(rawv[i + 2] << 16); hi[2 * i + 1] = __uint_as_float(rawv[i + 2] & 0xffff0000u); }
      *(LAS f32x4*)(vs + tv * 512 + e0) = lo; *(LAS f32x4*)(vs + tv * 512 + e0 + 4) = hi; }
    LBAR();
    { const int n = lane >> 3, m = lane & 7; float sx = 0.f;
#pragma unroll 8
      for (int d = 32 * w; d < 32 * w + 32; ++d) sx += qs[n * 260 + d] * kt[d * 8 + m];
      part[w * 64 + lane] = sx; }
    LBAR();
    if (tid < 64) { float sx = 0.f;
#pragma unroll
        for (int i = 0; i < 8; ++i) sx += part[i * 64 + tid];
        pm[tid] = (tid & 7) <= (tid >> 3) ? sx : 0.f; }
    LBAR();
    f32x4 v4[8];
#pragma unroll
    for (int m = 0; m < 8; ++m) v4[m] = *(const LAS f32x4*)(vs + m * 512 + e4);
    f32x4 oacc[4];
#pragma unroll
    for (int i = 0; i < 4; ++i) oacc[i] = (f32x4){0.f, 0.f, 0.f, 0.f};
#define RS_LOAD(dst, it0) do { _Pragma("unroll") for (int u = 0; u < 8; ++u) dst[u] = __builtin_nontemporal_load((const f32x4*)(S0 + (size_t)(4 * ((it0) + u)) * DV)); } while (0)
#define RS_PROC(src, it0) do { _Pragma("unroll") for (int u = 0; u < 8; ++u) { const int d = 4 * ((it0) + u) + fq; \
            const float a = fr < 8 ? qs[fr * 260 + d] : 0.f; \
            _Pragma("unroll") for (int i = 0; i < 4; ++i) oacc[i] = __builtin_amdgcn_mfma_f32_16x16x4f32(a, src[u][i], oacc[i], 0, 0, 0); \
            const f32x4 k0 = *(const LAS f32x4*)(kt + d * 8), k1 = *(const LAS f32x4*)(kt + d * 8 + 4); \
            const f32x4 acc = k0[0] * v4[0] + k0[1] * v4[1] + k0[2] * v4[2] + k0[3] * v4[3] + k1[0] * v4[4] + k1[1] * v4[5] + k1[2] * v4[6] + k1[3] * v4[7]; \
            __builtin_nontemporal_store(g8 * src[u] + g7 * acc, (f32x4*)(S1 + (size_t)(4 * ((it0) + u)) * DV)); } } while (0)
    for (int it0 = 0; it0 < 64; it0 += 16) {
        RS_LOAD(sb, it0 + 8);
        RS_PROC(sa, it0);
        { const int itn = it0 + 16 < 64 ? it0 + 16 : it0; RS_LOAD(sa, itn); }
        RS_PROC(sb, it0 + 8);
    }
#undef RS_LOAD
#undef RS_PROC
    if (fq < 2) {
#pragma unroll
        for (int j = 0; j < 4; ++j) { const int n = 4 * fq + j;
            f32x4 o = (f32x4){oacc[0][j], oacc[1][j], oacc[2][j], oacc[3][j]} * gam;
#pragma unroll
            for (int m = 0; m < 8; ++m) o += pm[n * 8 + m] * v4[m];
            u32x2 o2; o2.x = pk2(o[0], o[1]); o2.y = pk2(o[2], o[3]);
            *(u32x2*)(WSP(bf16, WS_O) + (size_t)(r0 + n) * HV + h * DV + e4) = o2; }
    }
}

__device__ __forceinline__ void p3_retention(Frame& F) {
    const bool stream_first = ((F.vcu >> 3) & 1) != 0;
    const int mode = F.mode;
    if (mode != 1 && stream_first) for (int it = F.vcu; it < 1024; it += F.G) ret_sample_item(F, it);
    if (mode != 2) for (int it = F.vcu; it < 256; it += F.G) ret_prompt_item(F, it);
    if (mode != 1 && !stream_first) for (int it = F.vcu; it < 1024; it += F.G) ret_sample_item(F, it);
}

__device__ __forceinline__ void p4_gn_gate(Frame& F) {
    const int gw = F.vcu * NWAVES + F.wave, NGW = F.G * NWAVES;
    const bf16* O = WSP(bf16, WS_O); const bf16* G = WSP(bf16, WS_G); bf16* A2 = WSP(bf16, WS_A2);
    for (int t = gw; t < M * NH; t += NGW) {
        const int r = t >> 3, h = t & 7; const size_t off = (size_t)r * HV + h * DV + 8 * F.lane;
        const u32x4 ov = *(const u32x4*)(O + off), gv = *(const u32x4*)(G + off);
        float o[8], g[8];
#pragma unroll
        for (int i = 0; i < 4; ++i) { o[2 * i] = __uint_as_float(ov[i] << 16); o[2 * i + 1] = __uint_as_float(ov[i] & 0xffff0000u); g[2 * i] = __uint_as_float(gv[i] << 16); g[2 * i + 1] = __uint_as_float(gv[i] & 0xffff0000u); }
        float s = 0.f;
#pragma unroll
        for (int i = 0; i < 8; ++i) s += o[i];
        const float mu = wave_sum(s) * (1.0f / DV); float q = 0.f;
#pragma unroll
        for (int i = 0; i < 8; ++i) { o[i] -= mu; q += o[i] * o[i]; }
        const float rstd = 1.0f / sqrtf(wave_sum(q) * (1.0f / DV) + 1e-6f);
        const f32x4 w0 = *(const f32x4*)(F.ret_gn_g + h * DV + 8 * F.lane), w1 = *(const f32x4*)(F.ret_gn_g + h * DV + 8 * F.lane + 4);
        float y[8];
#pragma unroll
        for (int i = 0; i < 4; ++i) { y[i] = g[i] * (o[i] * rstd * w0[i]); y[i + 4] = g[i + 4] * (o[i + 4] * rstd * w1[i]); }
        if (FP8O) { u32x2 out; out.x = pk4_fp8(y[0] * S_A2, y[1] * S_A2, y[2] * S_A2, y[3] * S_A2); out.y = pk4_fp8(y[4] * S_A2, y[5] * S_A2, y[6] * S_A2, y[7] * S_A2); *(u32x2*)((unsigned char*)A2 + off) = out; }
        else { u32x4 out; out.x = pk2(y[0], y[1]); out.y = pk2(y[2], y[3]); out.z = pk2(y[4], y[5]); out.w = pk2(y[6], y[7]); *(u32x4*)(A2 + off) = out; }
    }
}
}
namespace mk {
template <int WIN>
__device__ __forceinline__ void pool_walk(const bf16* xrow0  , int nrows, int first_tok  ,
                                          const LAS float* rs, int rs0, const float* hist  , f32x4 gain, f32x4 shift,
                                          bf16* arow0, float* hout  , bool sample, int c4) {
    f32x4 ring[16];
#pragma unroll
    for (int u = 0; u < 16; ++u) ring[u] = (f32x4){0.f, 0.f, 0.f, 0.f};
    for (int i0 = 0; i0 < nrows; i0 += 16) {
        f32x4 xv[16];
#pragma unroll
        for (int u = 0; u < 16; ++u) { int i = i0 + u; i = i < nrows ? i : nrows - 1; int t = first_tok + i; t = t < 0 ? 0 : t;
            xv[u] = (sample && i < 15) ? *(const f32x4*)(hist + (size_t)i * D + c4) : ld_bf4(xrow0 + (ptrdiff_t)(t - first_tok) * D + c4); }
#pragma unroll
        for (int u = 0; u < 16; ++u) {
            const int i = i0 + u;
            if (i < nrows) {
                const int t = first_tok + i;
                f32x4 hv = (f32x4){0.f, 0.f, 0.f, 0.f};
                if (sample && i < 15) hv = xv[u];
                else if (t >= 0) hv = xv[u] * rs[rs0 + i] * gain + shift;
                ring[u] = hv;
                if (i >= 15) {
                    f32x4 s = ring[u];
#pragma unroll
                    for (int j = 1; j < WIN; ++j) s += ring[(u - j) & 15];
                    const int cnt = sample ? WIN : (t + 1 < WIN ? t + 1 : WIN);
                    const f32x4 mm = s * (1.0f / (float)cnt) - hv;
                    u32x2 w; w.x = pk2(mm[0], mm[1]); w.y = pk2(mm[2], mm[3]);
                    *(u32x2*)(arow0 + (ptrdiff_t)i * D + c4) = w;
                }
                if (sample) { if (i >= 8) *(f32x4*)(hout + (size_t)(i - 8) * D + c4) = hv; }
                else if (t >= 2048 - 15) *(f32x4*)(hout + (size_t)(t - (2048 - 15)) * D + c4) = hv;
            }
        }
    }
}
__device__ __forceinline__ void pool_walk_dispatch(int gi, const bf16* xrow0, int nrows, int first_tok, const LAS float* rs, int rs0, const float* hist, f32x4 gain, f32x4 shift, bf16* arow0, float* hout, bool sample, int c4) {
    if (gi == 0) pool_walk<2>(xrow0, nrows, first_tok, rs, rs0, hist, gain, shift, arow0, hout, sample, c4);
    else if (gi == 1) pool_walk<4>(xrow0, nrows, first_tok, rs, rs0, hist, gain, shift, arow0, hout, sample, c4);
    else if (gi == 2) pool_walk<8>(xrow0, nrows, first_tok, rs, rs0, hist, gain, shift, arow0, hout, sample, c4);
    else pool_walk<16>(xrow0, nrows, first_tok, rs, rs0, hist, gain, shift, arow0, hout, sample, c4);
}
__device__ __forceinline__ float row_rstd(Frame& F, int r, bf16* xcur, const bf16* xprev, const bf16* slab, int nparts, const float* gate_l  ) {
    f32x4 v[8];
    if (r < MP) {
#pragma unroll
        for (int j = 0; j < 8; ++j) v[j] = ld_bf4(xcur + (size_t)r * D + 4 * (F.lane + 64 * j)); }
    else { const float* gate = gate_l + (size_t)seq_of(r) * NMOD;
#pragma unroll
        for (int j = 0; j < 8; ++j) { const int c = 4 * (F.lane + 64 * j);
            f32x4 sl[8];
#pragma unroll
            for (int p = 0; p < 8; ++p) sl[p] = ld_bf4(slab + ((size_t)p * MS + (r - MP)) * D + c);
            const f32x4 xp = ld_bf4(xprev + (size_t)r * D + c), gt = *(const f32x4*)(gate + c);
            const f32x4 t = ((sl[0] + sl[1]) + (sl[2] + sl[3])) + ((sl[4] + sl[5]) + (sl[6] + sl[7]));
            v[j] = xp + gt * t;
            { u32x2 w; w.x = pk2(v[j][0], v[j][1]); w.y = pk2(v[j][2], v[j][3]); *(u32x2*)(xcur + (size_t)r * D + c) = w; }
            if ((j & 3) == 3) asm volatile("" ::: "memory"); } }
    float ss = 0.f;
#pragma unroll
    for (int j = 0; j < 8; ++j) ss += (v[j][0] * v[j][0] + v[j][1] * v[j][1]) + (v[j][2] * v[j][2] + v[j][3] * v[j][3]);
    return 1.0f / sqrtf(wave_sum(ss) * (1.0f / D) + 1e-6f);
}
__device__ __forceinline__ void p9_pool_prep(Frame& F, bf16* xcur, const bf16* xprev, const bf16* slab, int nparts, const float* mod_prev  , const float* mod1, const float* rowss) {
    LAS float* rs = (LAS float*)F.lds;
    const int c4 = 4 * F.tid, gi = F.tid >> 7;
    const float* g = F.norm_mix_g + D;
    bf16* A = WSP(bf16, WS_A);
    for (int it = F.vcu; it < 256; it += F.G) {
        __syncthreads();
        const int sb = it < 128 ? it : -1;
        { const int b = it >> 6, ta = 32 * (it & 63), nrows = 47;
            if (F.tid < nrows) { const int t = ta - 15 + F.tid; if (t >= 0) rs[F.tid] = 1.0f / sqrtf(rowss[b * 2048 + t] * (1.0f / D) + 1e-6f); }
            if (sb >= 0) { const float r = row_rstd(F, MP + 8 * sb + F.wave, xcur, xprev, slab, nparts, mod_prev + 5 * D); if (F.lane == 0) rs[64 + F.wave] = r; VM_WAIT(); }
            __syncthreads();
            const float* ms = mod1 + (size_t)b * NMOD;
            const f32x4 gain = *(const f32x4*)(g + c4) * (*(const f32x4*)(ms + 1 * D + c4) + 1.0f), shift = *(const f32x4*)(ms + c4);
            pool_walk_dispatch(gi, xcur + (ptrdiff_t)(b * 2048 + ta - 15) * D, nrows, ta - 15, rs, 0, nullptr, gain, shift, A + (ptrdiff_t)(b * 2048 + ta - 15) * D, F.sp_p + (size_t)b * 15 * D, false, c4); }
        if (sb >= 0) { const int b = sb; const float* ms = mod1 + (size_t)(4 + b) * NMOD;
            const f32x4 gain = *(const f32x4*)(g + c4) * (*(const f32x4*)(ms + 1 * D + c4) + 1.0f), shift = *(const f32x4*)(ms + c4);
            pool_walk_dispatch(gi, xcur + (ptrdiff_t)(MP + 8 * b - 15) * D, 23, -15, rs, 64 - 15, F.state_pool + (size_t)b * 15 * D, gain, shift, A + (ptrdiff_t)(MP + 8 * b - 15) * D, F.sp_s + (size_t)b * 15 * D, true, c4); }
    }
}

__global__ void __launch_bounds__(NTHREADS, 2) mk_fwd(Args args) {
    extern __shared__ __attribute__((aligned(16))) unsigned char lds_raw[];
    Frame F;
    F.lds = (LAS unsigned char*)lds_raw;
    F.tid = threadIdx.x; F.lane = F.tid & 63; F.wave = __builtin_amdgcn_readfirstlane(F.tid >> 6);
    F.G = gridDim.x; { const int bx = blockIdx.x; F.vcu = (F.G % 8 == 0) ? (bx % 8) * (F.G / 8) + bx / 8 : bx; }
    F.x_p = args.in[0]; F.x_s = args.in[1]; F.c_p = args.in[2]; F.c_s = args.in[3]; F.state_ret = args.in[4]; F.state_pool = args.in[5]; F.norm_mix_g = args.in[6]; F.norm_ffn_g = args.in[7];
    F.ada_w = args.in[8]; F.ada_b = args.in[9]; F.ret_w_in = args.in[10]; F.ret_gn_g = args.in[11]; F.ret_w_out = args.in[12]; F.pool_w = args.in[13]; F.pool_scale = args.in[14];
    F.ffn_w_in = args.in[15]; F.ffn_w_out = args.in[16]; F.final_g = args.in[17];
    F.y = args.out; F.sr_p = F.y + (size_t)M * D; F.sp_p = F.sr_p + (size_t)4 * NH * DK * DV; F.sr_s = F.sp_p + (size_t)4 * 15 * D; F.sp_s = F.sr_s + (size_t)128 * NH * DK * DV;
    F.ws = args.ws; F.mode = MK_EXPERIMENT ? args.mode : 0;
    volatile LAS unsigned* MISC = (volatile LAS unsigned*)(F.lds + MISC_OFF);
    if (F.tid < 32) MISC[F.tid] = 0u;
    __syncthreads();
    unsigned* ctl = (unsigned*)(F.ws + WS_CTL);
    const int lo = args.ph_lo, hi = args.ph_hi;
    const bool use_bar = (hi - lo) > 1;
    XcdBarrier bar; bar.bar = ctl + CW_BAR; bar.x = 0; bar.st = nullptr;
    if (use_bar) bar = xcd_barrier_post(ctl + CW_BAR, MISC + 8);
#ifndef MK_PHASE_MASK
#define MK_PHASE_MASK 0x7fff
#endif
#define IN(k) ((((MK_PHASE_MASK) >> (k)) & 1) && lo <= (k) && (k) < hi)
#if defined(MK_STAMPS)
    unsigned long long* stp = (unsigned long long*)(F.ws + ((size_t)900 << 20)) + (size_t)blockIdx.x * 64;
    if (F.tid == 0) { stp[60] = __builtin_amdgcn_s_memrealtime(); stp[62] = (unsigned long long)clock64(); }
    unsigned long long* stq = (unsigned long long*)(F.ws + ((size_t)901 << 20)) + (size_t)blockIdx.x * 64;
#define GST(k) , stq + 4 * (k)
#define SEAM(k) do { if (IN(k) && IN((k) + 1)) { if (F.tid == 0) { stp[2 * (k)] = __builtin_amdgcn_s_memrealtime(); stp[32 + 2 * (k)] = (unsigned long long)clock64(); } xcd_barrier(bar); if (F.tid == 0) { stp[2 * (k) + 1] = __builtin_amdgcn_s_memrealtime(); stp[32 + 2 * (k) + 1] = (unsigned long long)clock64(); } } } while (0)
#else
#define GST(k)
#define SEAM(k) do { if (IN(k) && IN((k) + 1)) xcd_barrier(bar); } while (0)
#endif
    float* mod0 = WSP(float, WS_MOD); float* mod1 = mod0 + (size_t)NSEQ * NMOD;
    bf16* X1 = WSP(bf16, WS_X1); bf16* X2 = WSP(bf16, WS_X2); bf16* SLAB = WSP(bf16, WS_SLAB);
    bf16* A = WSP(bf16, WS_A);
    const float* xs_shift = F.x_s - (size_t)MP * D;
    const int ord_c = (int)blockIdx.x;

    if (IN(0)) { p0_prologue(F); } SEAM(0);
    if (IN(1)) { norm_rows<0, 0, 0, false>(F, nullptr, nullptr, nullptr, nullptr, mod0, 0, nullptr, F.norm_mix_g, 0, 1, A, nullptr);
        transpose_range(F, TR_P0_END + F.vcu * NWAVES + F.wave, TR_P1_END, F.G * NWAVES, (LAS float*)(F.lds + F.wave * 16384)); } SEAM(1);
    if (IN(2)) {
        pg8::Gemm g{A, WSP(bf16, WS_WIN), D * 2, D * 2}; pg8::OrdStatic S; S.init(M, NPROJ, D * 2, F.G, ord_c);
        pg8::EpiProj E{WSP(bf16, WS_Q), WSP(bf16, WS_K), WSP(bf16, WS_V), WSP(bf16, WS_G), WSP(float2, WS_ROPE)};
        pg8::gemm_phase<false>(F.lds, g, S, E GST(2));
        { const int nfull = S.nwg % F.G;
          if (nfull > 0) transpose_tail(F, TR_P1_END, TR_P2_END, ord_c >= nfull ? ord_c - nfull : -1, F.G - nfull);
          else transpose_tail(F, TR_P1_END, TR_P2_END, ord_c, F.G); }
    } SEAM(2);
    if (IN(3)) { p3_retention(F); } SEAM(3);
    if (IN(4)) { p4_gn_gate(F); } SEAM(4);
    if (IN(5)) {
        pg8::Gemm g{WSP(bf16, WS_A2), WSP(bf16, WS_WOUT), HV * OES, HV * OES}; pg8::OrdSplit S; S.init(HV * OES, 8, 0, F.G, ord_c);
        pg8::EpiResid<0, true> E{F.x_p, X1, mod0 + 2 * D, SLAB, nullptr, FP8O ? 1.0f / (S_A2 * S_WO) : 1.0f};
        pg8::gemm_phase<FP8O>(F.lds, g, S, E GST(5));
    } SEAM(5);
    if (IN(6)) { norm_rows<1, FP8 ? 2 : 0, 8, true>(F, X1, X1, xs_shift, SLAB, mod0, 2, nullptr, F.norm_ffn_g, 3, 4, A, nullptr); } SEAM(6);
    if (IN(7)) {
        pg8::Gemm g{A, F.ws + WS_WF1, D * FES, D * FES}; pg8::OrdStatic S; S.init(M, 2 * FF, D * FES, F.G, ord_c);
        pg8::EpiSwiglu<FP8> E{F.ws + WS_HID
#if MK_EXPERIMENT
            , F.mode
#endif
            };
        pg8::gemm_phase<FP8>(F.lds, g, S, E GST(7));
        { const int nfull = S.nwg % F.G;
          if (nfull > 0) transpose_tail(F, TR_P2_END, TR_P7_END, ord_c >= nfull ? ord_c - nfull : -1, F.G - nfull);
          else transpose_tail(F, TR_P2_END, TR_P7_END, ord_c, F.G); }
    } SEAM(7);
    if (IN(8)) {
        pg8::Gemm g{F.ws + WS_HID, F.ws + WS_WF2, FF * FES, FF * FES}; pg8::OrdSplit S; S.init(FF * FES, 8, 0, F.G, ord_c);
        pg8::EpiResid<2, false> E{X1, X2, mod0 + 5 * D, SLAB, (float*)(ctl + CW_ROWSS), FP8 ? 1.0f / (S_HID * S_W2) : 1.0f};
        pg8::gemm_phase<FP8>(F.lds, g, S, E GST(8));
    } SEAM(8);
    if (IN(9)) { p9_pool_prep(F, X2, X1, SLAB, 8, mod0, mod1, (const float*)(ctl + CW_ROWSS)); } SEAM(9);
    if (IN(10)) {
        pg8::Gemm g{A, WSP(bf16, WS_WPOOL), D * 2, 512 * 2}; pg8::OrdSplit S; S.init(512 * 2, 2, 1, F.G, ord_c);
        pg8::EpiResid<1, false> E{X2, X1, mod1 + 2 * D, SLAB, const_cast<float*>(F.pool_scale), 1.0f};
        pg8::gemm_phase<false>(F.lds, g, S, E GST(10));
    } SEAM(10);
    if (IN(11)) { norm_rows<1, FP8 ? 2 : 0, 2, false>(F, X1, X1, X2, SLAB, mod1, 2, F.pool_scale, F.norm_ffn_g + D, 3, 4, A, nullptr); } SEAM(11);
    if (IN(12)) {
        pg8::Gemm g{A, F.ws + WS_WF1 + (size_t)2 * FF * D * FES, D * FES, D * FES}; pg8::OrdStatic S; S.init(M, 2 * FF, D * FES, F.G, ord_c);
        pg8::EpiSwiglu<FP8> E{F.ws + WS_HID
#if MK_EXPERIMENT
            , F.mode
#endif
            };
        pg8::gemm_phase<FP8>(F.lds, g, S, E GST(12));
        { const int nfull = S.nwg % F.G;
          if (nfull > 0) transpose_tail(F, TR_P7_END, TI_TOTAL, ord_c >= nfull ? ord_c - nfull : -1, F.G - nfull);
          else transpose_tail(F, TR_P7_END, TI_TOTAL, ord_c, F.G); }
    } SEAM(12);
    if (IN(13)) {
        pg8::Gemm g{F.ws + WS_HID, F.ws + WS_WF2 + (size_t)D * FF * FES, FF * FES, FF * FES}; pg8::OrdSplit S; S.init(FF * FES, 8, 0, F.G, ord_c);
        pg8::EpiResid<0, false> E{X1, X2, mod1 + 5 * D, SLAB, nullptr, FP8 ? 1.0f / (S_HID * S_W2) : 1.0f};
        pg8::gemm_phase<FP8>(F.lds, g, S, E GST(13));
    } SEAM(13);
    if (IN(14)) { norm_rows<1, 1, 8, false>(F, X2, X2, X1, SLAB, mod1, 5, nullptr, F.final_g, 0, 0, nullptr, F.y); }
#if defined(MK_STAMPS)
    VM_WAIT(); if (F.tid == 0) { stp[61] = __builtin_amdgcn_s_memrealtime(); stp[63] = (unsigned long long)clock64(); }
#endif
#undef IN
#undef SEAM
#undef GST
}

static int g_grid = 0;
static bool mk_setup() {
    if (g_grid) return g_grid > 0;
    int dev = 0, cus = 0, per_cu = 0;
    if (hipGetDevice(&dev) != hipSuccess || hipDeviceGetAttribute(&cus, hipDeviceAttributeMultiprocessorCount, dev) != hipSuccess) { g_grid = -1; return false; }
    if (hipFuncSetAttribute((const void*)mk_fwd, hipFuncAttributeMaxDynamicSharedMemorySize, LDS_BYTES) != hipSuccess) { fprintf(stderr, "mk: hipFuncSetAttribute failed\n"); g_grid = -1; return false; }
    if (hipOccupancyMaxActiveBlocksPerMultiprocessor(&per_cu, (const void*)mk_fwd, NTHREADS, LDS_BYTES) != hipSuccess || per_cu < 1) fprintf(stderr, "mk: occupancy query says %d\n", per_cu);
    (void)hipGetLastError();
    g_grid = cus;
    return true;
}
static void mk_launch(void* const* d_in, float* out, unsigned char* ws, int lo, int hi, hipStream_t st, int mode = 0) {
    Args a{};
    for (int i = 0; i < 18; ++i) a.in[i] = (const float*)d_in[i];
    a.out = out; a.ws = ws; a.ph_lo = lo; a.ph_hi = hi; a.mode = mode; a.pad = 0;
    hipLaunchKernelGGL(mk_fwd, dim3(g_grid), dim3(NTHREADS), LDS_BYTES, st, a);
}
}
extern "C" void kernel_launch(void* const* d_in, const int* in_sizes, int n_in, void* d_out, int out_size, void* d_ws, size_t ws_size, hipStream_t stream) {
    if (!mk::mk_setup()) return;
    hipMemsetAsync(d_ws, 0, mk::CTL_ZERO_BYTES, stream);
    mk::mk_launch(d_in, (float*)d_out, (unsigned char*)d_ws, 0, 15, stream);
}
```
